# Optimizing an MI355X kernel written in HIP

```python
import math
import jax, jax.numpy as jnp
from jax import lax
import numpy as np

D_MODEL = 1024
BATCH = 4
SEQ = 4096
DEPTH = 1

GLA_HEADS = 4
GLA_DK = (D_MODEL // 2) // GLA_HEADS
GLA_DV = D_MODEL // GLA_HEADS
GLA_GATE_RANK = 16
GLA_GATE_NORMALIZER = 16.0
HGRN_EXPAND = 128
HGRN_HEADS = D_MODEL // HGRN_EXPAND
HGRN_DK = HGRN_EXPAND
HGRN_DV = D_MODEL // HGRN_HEADS

GLA_QK = GLA_HEADS * GLA_DK
GLA_V = GLA_HEADS * GLA_DV
HG_K = HGRN_HEADS * HGRN_DK
HG_V = HGRN_HEADS * HGRN_DV
SPLIT_SIZES = (GLA_QK, GLA_QK, GLA_V, GLA_V, GLA_GATE_RANK, GLA_GATE_RANK,
               HG_K, HG_K, HG_K, HG_V, HG_V, D_MODEL, D_MODEL)
PROJ_DIM = sum(SPLIT_SIZES)

CHUNK = 64
RMS_EPS = 1e-6
LN_EPS = 1e-5
DEEPNORM_ALPHA = (2.0 * DEPTH) ** 0.25
DEEPNORM_BETA = (8.0 * DEPTH) ** -0.25

kernel_name = 'hybrid_gla_hgrn2_bidir_deepnorm'


def _split_columns(p):
    points = np.cumsum(np.array(SPLIT_SIZES))[:-1].tolist()
    return jnp.split(p, points, axis=-1)


def _heads(a, h):
    b, t, c = a.shape
    return a.reshape(b, t, h, c // h)


def chunk_gated_linear_attn(q, k, v, g):
    B, T, H, dk = q.shape
    dv = v.shape[-1]
    n = T // CHUNK

    def to_chunks(a):
        return a.reshape(B, n, CHUNK, H, a.shape[-1]).transpose(1, 0, 3, 2, 4)

    qc, kc, vc, gc = to_chunks(q), to_chunks(k), to_chunks(v), to_chunks(g)
    mask = jnp.tril(jnp.ones((CHUNK, CHUNK), dtype=bool))[None, None, :, :, None]

    def step(S, inp):
        qi, ki, vi, gi = inp
        b = jnp.cumsum(gi, axis=2)
        b_last = b[:, :, -1:, :]
        o_inter = jnp.einsum('bhcd,bhde->bhce', qi * jnp.exp(b), S)
        rel = jnp.where(mask, b[:, :, :, None, :] - b[:, :, None, :, :], -jnp.inf)
        scores = jnp.einsum('bhid,bhjd,bhijd->bhij', qi, ki, jnp.exp(rel))
        o = o_inter + jnp.einsum('bhij,bhje->bhie', scores, vi)
        S = (jnp.exp(b_last[:, :, 0, :])[..., None] * S
             + jnp.einsum('bhjd,bhje->bhde', ki * jnp.exp(b_last - b), vi))
        return S, o

    S0 = jnp.zeros((B, H, dk, dv), jnp.float32)
    _, o = lax.scan(step, S0, (qc, kc, vc, gc))
    return o.transpose(1, 0, 3, 2, 4).reshape(B, T, H, dv)


def bidirectional_scan(q, k_f, k_b, v, g_f, g_b):
    fwd = chunk_gated_linear_attn(q, k_f, v, g_f)
    flip = lambda a: jnp.flip(a, axis=1)
    bwd = flip(chunk_gated_linear_attn(flip(q), flip(k_b), flip(v), flip(g_b)))
    return fwd + bwd


def head_rmsnorm(o, gain):
    return o * lax.rsqrt(jnp.mean(o * o, axis=-1, keepdims=True) + RMS_EPS) * gain


def layer_norm(x, g, b):
    mu = jnp.mean(x, axis=-1, keepdims=True)
    xc = x - mu
    var = jnp.mean(xc * xc, axis=-1, keepdims=True)
    return xc * lax.rsqrt(var + LN_EPS) * g + b


def hybrid_layer(h, layer, w_in, gk_up_f, gk_bias_f, gk_up_b, gk_bias_b, gla_norm_g,
                 lb_logits_f, lb_logits_b, hgrn_norm_g, w_branch_gla, w_branch_hgrn,
                 w_out, ln_g, ln_b):
    f32 = jnp.float32
    B, T, _ = h.shape
    p = jnp.einsum('btd,dp->btp', h, w_in)
    (a_q, a_k, a_v, a_gate, a_lr_f, a_lr_b,
     h_q, h_f_f, h_f_b, h_i, h_gate, m_gla, m_hgrn) = _split_columns(p)

    g_f = jax.nn.log_sigmoid(a_lr_f @ gk_up_f + gk_bias_f) / GLA_GATE_NORMALIZER
    g_b = jax.nn.log_sigmoid(a_lr_b @ gk_up_b + gk_bias_b) / GLA_GATE_NORMALIZER
    qa = _heads(a_q, GLA_HEADS) * (GLA_DK ** -0.5)
    ka = _heads(a_k, GLA_HEADS)
    o_a = bidirectional_scan(qa, ka, ka, _heads(a_v, GLA_HEADS),
                             _heads(g_f, GLA_HEADS), _heads(g_b, GLA_HEADS))
    o_a = head_rmsnorm(o_a, gla_norm_g).reshape(B, T, GLA_V) * jax.nn.silu(a_gate)
    y_gla = o_a @ w_branch_gla

    lb_f = jnp.cumsum(jax.nn.softmax(lb_logits_f, axis=0), axis=0)[layer]
    lb_b = jnp.cumsum(jax.nn.softmax(lb_logits_b, axis=0), axis=0)[layer]
    f_f = lb_f + (1.0 - lb_f) * jax.nn.sigmoid(h_f_f)
    f_b = lb_b + (1.0 - lb_b) * jax.nn.sigmoid(h_f_b)
    qh = _heads(jax.nn.silu(h_q), HGRN_HEADS) * (HGRN_DK ** -0.5)
    o_h = bidirectional_scan(qh, _heads(1.0 - f_f, HGRN_HEADS), _heads(1.0 - f_b, HGRN_HEADS),
                             _heads(h_i, HGRN_HEADS),
                             _heads(jnp.log(f_f), HGRN_HEADS), _heads(jnp.log(f_b), HGRN_HEADS))
    o_h = head_rmsnorm(o_h, hgrn_norm_g).reshape(B, T, HG_V) * jax.nn.silu(h_gate)
    y_hgrn = o_h @ w_branch_hgrn

    y = jax.nn.sigmoid(m_gla) * y_gla + jax.nn.sigmoid(m_hgrn) * y_hgrn
    y = y @ w_out
    return layer_norm(DEEPNORM_ALPHA * h + y, ln_g, ln_b).astype(f32)


def setup_inputs(seed: int = 0) -> dict:
    key = jax.random.key(seed)
    ks = jax.random.split(key, 16)
    n = jax.random.normal
    D = D_MODEL
    return {
        'x': n(ks[0], (BATCH, SEQ, D), jnp.float32),
        'w_in': n(ks[1], (DEPTH, D, PROJ_DIM), jnp.float32) * D ** -0.5,
        'gla_gk_up_f': n(ks[2], (DEPTH, GLA_GATE_RANK, GLA_QK), jnp.float32) * GLA_GATE_RANK ** -0.5,
        'gla_gk_bias_f': n(ks[3], (DEPTH, GLA_QK), jnp.float32) * 0.02,
        'gla_gk_up_b': n(ks[4], (DEPTH, GLA_GATE_RANK, GLA_QK), jnp.float32) * GLA_GATE_RANK ** -0.5,
        'gla_gk_bias_b': n(ks[5], (DEPTH, GLA_QK), jnp.float32) * 0.02,
        'gla_norm_g': 1.0 + 0.02 * n(ks[6], (DEPTH, GLA_DV), jnp.float32),
        'hgrn_lb_logits_f': n(ks[7], (DEPTH + 1, HG_K), jnp.float32) * 0.1,
        'hgrn_lb_logits_b': n(ks[8], (DEPTH + 1, HG_K), jnp.float32) * 0.1,
        'hgrn_norm_g': 1.0 + 0.02 * n(ks[9], (DEPTH, HGRN_DV), jnp.float32),
        'w_branch_gla': n(ks[10], (DEPTH, GLA_V, D), jnp.float32) * (GLA_V ** -0.5) * DEEPNORM_BETA,
        'w_branch_hgrn': n(ks[11], (DEPTH, HG_V, D), jnp.float32) * (HG_V ** -0.5) * DEEPNORM_BETA,
        'w_out': n(ks[12], (DEPTH, D, D), jnp.float32) * (D ** -0.5) * DEEPNORM_BETA,
        'ln_g': 1.0 + 0.02 * n(ks[13], (DEPTH, D), jnp.float32),
        'ln_b': 0.02 * n(ks[14], (DEPTH, D), jnp.float32),
    }


def reference(x, w_in, gla_gk_up_f, gla_gk_bias_f, gla_gk_up_b, gla_gk_bias_b, gla_norm_g,
              hgrn_lb_logits_f, hgrn_lb_logits_b, hgrn_norm_g, w_branch_gla, w_branch_hgrn,
              w_out, ln_g, ln_b):
    f32 = jnp.float32
    c = lambda a: a.astype(f32)
    h = c(x)
    lbf = c(hgrn_lb_logits_f)
    lbb = c(hgrn_lb_logits_b)
    for layer in range(DEPTH):
        h = hybrid_layer(h, layer, c(w_in[layer]), c(gla_gk_up_f[layer]), c(gla_gk_bias_f[layer]),
                         c(gla_gk_up_b[layer]), c(gla_gk_bias_b[layer]), c(gla_norm_g[layer]),
                         lbf, lbb, c(hgrn_norm_g[layer]), c(w_branch_gla[layer]),
                         c(w_branch_hgrn[layer]), c(w_out[layer]), c(ln_g[layer]), c(ln_b[layer]))
    return h.astype(x.dtype)
```

```cpp
#include <hip/hip_runtime.h>
#include <hip/hip_cooperative_groups.h>
#include <cstdio>
#include <cstdint>
namespace cg = cooperative_groups;

#define LAS __attribute__((address_space(3)))
typedef unsigned short u16;
typedef short bf16x8 __attribute__((ext_vector_type(8)));
typedef float f32x4 __attribute__((ext_vector_type(4)));
typedef float f32x2 __attribute__((ext_vector_type(2)));
typedef unsigned u32x4 __attribute__((ext_vector_type(4)));
typedef unsigned u32x2 __attribute__((ext_vector_type(2)));
typedef _Float16 h16x2 __attribute__((ext_vector_type(2)));

constexpr int SEQ = 4096, MTOK = 16384, DM = 1024, NIN = 10272;
constexpr size_t MiB = 1024ull * 1024ull;
constexpr size_t OFF_BAR = 61 * MiB;
#define XCD_BAR_WORDS 3456
constexpr size_t OFF_XB = 0, OFF_WINT = 32 * MiB, OFF_WGT = 54 * MiB, OFF_WHT = 56 * MiB, OFF_WOT = 58 * MiB, OFF_LB = 60 * MiB;
constexpr size_t OFF_Q = 64 * MiB, OFF_K = 80 * MiB, OFF_V = 96 * MiB, OFF_EAF = 128 * MiB, OFF_EAB = 144 * MiB, OFF_HQ = 160 * MiB, OFF_HV = 192 * MiB, OFF_EF = 224 * MiB;
constexpr size_t OFF_GATEA = 64 * MiB, OFF_HGATE = 96 * MiB, OFF_MG = 128 * MiB, OFF_MH = 160 * MiB, OFF_A1 = 192 * MiB;
constexpr size_t X_KEF = 0, X_EB = 32 * MiB, X_KEB = 64 * MiB, X_OHF = 96 * MiB, X_OHB = 128 * MiB, X_Y = 0;
__device__ __attribute__((aligned(256))) unsigned char g_ext[160 * MiB];
constexpr size_t OFF_OAF = 0, OFF_OAB = 32 * MiB;

struct Params {
    const float *x, *w_in, *up_f, *bias_f, *up_b, *bias_b, *gla_g, *lbl_f, *lbl_b, *hg_g, *w_gla, *w_hgrn, *w_out, *ln_g, *ln_b;
    float* out;
    unsigned char* ws;
};

typedef __bf16 bf16x2_t __attribute__((ext_vector_type(2)));
__device__ __forceinline__ unsigned pk_bf16(float lo, float hi) { const f32x2 v = {lo, hi}; return __builtin_bit_cast(unsigned, __builtin_convertvector(v, bf16x2_t)); }
__device__ __forceinline__ float bflo(unsigned w) { return __uint_as_float(w << 16); }
__device__ __forceinline__ float bfhi(unsigned w) { return __uint_as_float(w & 0xffff0000u); }
__device__ __forceinline__ float sigmoidf_(float v) { return __builtin_amdgcn_rcpf(1.f + __expf(-v)); }
__device__ __forceinline__ unsigned pk_h16(float lo, float hi) { h16x2 h; h.x = (_Float16)lo; h.y = (_Float16)hi; return __builtin_bit_cast(unsigned, h); }

template <int CTRL> __device__ __forceinline__ float dppf(float old, float v) { return __int_as_float(__builtin_amdgcn_update_dpp(__float_as_int(old), __float_as_int(v), CTRL, 0xf, 0xf, false)); }

constexpr int BM = 256, BK = 64, HALF = 128, HTB = HALF * BK * 2;
__device__ __forceinline__ int lds_byte(int r, int c) { const int st = (r >> 4) * 2 + (c >> 5), rr = r & 15, cc = c & 31, ob = rr * 64 + cc * 2; return st * 1024 + (ob ^ (((ob >> 9) & 1) << 5)); }
__device__ __forceinline__ void stage_rc(int b, int& R, int& C) { const int st = b / 1024, sb = b % 1024, swz = sb ^ (((sb >> 9) & 1) << 5); R = (st >> 1) * 16 + swz / 64; C = (st & 1) * 32 + (swz % 64) / 2; }
__device__ __forceinline__ int perm32(int rho) { const int n = rho >> 4, i = rho & 15; return 8 * (i >> 2) + 4 * n + (i & 3); }

struct Unit { const char* a; const char* b; int pm; int pn; };

struct Sched {
    int phase;
    int nN, ntiles, nsub, G, c;
    const unsigned char* ws;
    __device__ __forceinline__ bool next(int ui, Unit& u) const {
        const int tile = (nsub == 2) ? (ui >> 1) : ui, g = (nsub == 2) ? (ui & 1) : 0;
        const long L = (long)tile * G + c;
        if (L >= ntiles) return false;
        int wgid = (int)L;
        { const int q = ntiles / 8, r = ntiles % 8, xcd = wgid % 8, off = wgid / 8; wgid = (xcd < r ? xcd * (q + 1) : r * (q + 1) + (xcd - r) * q) + off; }
        const int nM = 64, nig = 8 * nN, gid = wgid / nig, fm = gid * 8, gsz = (nM - fm) < 8 ? (nM - fm) : 8;
        const int pm = fm + ((wgid % nig) % gsz), j = (wgid % nig) / gsz;
        u.pm = pm;
        if (phase == 1 || phase == 2) { const int pn = (phase == 1) ? j : j + 28; u.pn = pn;
            u.a = (const char*)ws + OFF_XB + (size_t)pm * 256 * 1024 * 2; u.b = (const char*)ws + OFF_WINT + (size_t)pn * 256 * 1024 * 2; }
        else if (phase == 4) { u.pn = j + 4 * g;
            u.a = (const char*)ws + OFF_A1 + (size_t)pm * 256 * 2048 * 2 + (size_t)g * 1024 * 2; u.b = (const char*)ws + (g ? OFF_WHT : OFF_WGT) + (size_t)j * 256 * 1024 * 2; }
        else { u.pn = j;
            u.a = (const char*)g_ext + X_Y + (size_t)pm * 256 * 1024 * 2; u.b = (const char*)ws + OFF_WOT + (size_t)j * 256 * 1024 * 2; }
        return true;
    }
};

__device__ __forceinline__ void unpack8(const u32x4& w, float (&f)[8]) {
    f[0] = bflo(w.x); f[1] = bfhi(w.x); f[2] = bflo(w.y); f[3] = bfhi(w.y); f[4] = bflo(w.z); f[5] = bfhi(w.z); f[6] = bflo(w.w); f[7] = bfhi(w.w);
}
__device__ __forceinline__ u32x4 pack8(const f32x4& v0, const f32x4& v1) { u32x4 w; w.x = pk_bf16(v0[0], v0[1]); w.y = pk_bf16(v0[2], v0[3]); w.z = pk_bf16(v1[0], v1[1]); w.w = pk_bf16(v1[2], v1[3]); return w; }

template <bool HG, bool BWD>
__device__ __forceinline__ void decay_epi(const f32x4 (&acc)[2][2][4][2], u16* D, u16* D2, const float* cvec, int ld, int col0, int rbase, int cbase) {
    int tidx = threadIdx.x; asm volatile("" : "+v"(tidx));
    const int lane = tidx & 63;
    const int srcl = BWD ? (lane & 48) : ((lane & 48) | 15);
#pragma unroll
    for (int bj = 0; bj < 2; ++bj)
#pragma unroll
        for (int n = 0; n < 2; ++n) {
            const int cc = col0 + bj * 128 + cbase + 4 * n;
            const f32x4 cv = *(const f32x4*)(cvec + cc);
#pragma unroll
            for (int ai = 0; ai < 2; ++ai) {
                f32x4 sv[4], omf[4];
#pragma unroll
                for (int m = 0; m < 4; ++m)
#pragma unroll
                    for (int e = 0; e < 4; ++e) { const float a = acc[ai][bj][m][n][e];
                        if (HG) { const float f = cv[e] + (1.f - cv[e]) * sigmoidf_(a); sv[m][e] = f; omf[m][e] = 1.f - f; }
                        else { const float z = a + cv[e]; const float g = (fminf(z, 0.f) - __logf(1.f + __expf(-fabsf(z)))) * 0.0625f; sv[m][e] = g; } }
#pragma unroll
                for (int m = 0; m < 4; ++m)
#pragma unroll
                    for (int e = 0; e < 4; ++e) { float s = sv[m][e];
                        if (HG) { if (BWD) { s *= dppf<0x101>(1.f, s); s *= dppf<0x102>(1.f, s); s *= dppf<0x104>(1.f, s); s *= dppf<0x108>(1.f, s); }
                                  else { s *= dppf<0x111>(1.f, s); s *= dppf<0x112>(1.f, s); s *= dppf<0x114>(1.f, s); s *= dppf<0x118>(1.f, s); } }
                        else { if (BWD) { s += dppf<0x101>(0.f, s); s += dppf<0x102>(0.f, s); s += dppf<0x104>(0.f, s); s += dppf<0x108>(0.f, s); }
                               else { s += dppf<0x111>(0.f, s); s += dppf<0x112>(0.f, s); s += dppf<0x114>(0.f, s); s += dppf<0x118>(0.f, s); } }
                        sv[m][e] = s; }
                __builtin_amdgcn_sched_barrier(0);
#pragma unroll
                for (int e = 0; e < 4; ++e) {
                    float off = HG ? 1.f : 0.f;
#pragma unroll
                    for (int mm = 0; mm < 4; ++mm) { constexpr int dummy = 0; (void)dummy;
                        const int m = BWD ? 3 - mm : mm;
                        const float tot = __shfl(sv[m][e], srcl);
                        if (HG) { sv[m][e] *= off; off *= tot; } else { sv[m][e] += off; off += tot; } }
                }
#pragma unroll
                for (int m = 0; m < 4; ++m) { const unsigned idx = (unsigned)((rbase + ai * 128 + m * 16) * ld + cc);
                    f32x4 e0;
#pragma unroll
                    for (int e = 0; e < 4; ++e) e0[e] = HG ? sv[m][e] : __expf(sv[m][e]);
                    *(u32x2*)(D + idx) = (u32x2){pk_bf16(e0[0], e0[1]), pk_bf16(e0[2], e0[3])};
                    if (HG) { f32x4 k0;
#pragma unroll
                        for (int e = 0; e < 4; ++e) k0[e] = omf[m][e] * __builtin_amdgcn_rcpf(e0[e]);
                        *(u32x2*)(D2 + idx) = (u32x2){pk_bf16(k0[0], k0[1]), pk_bf16(k0[2], k0[3])}; }
                    __builtin_amdgcn_sched_barrier(0); }
                __builtin_amdgcn_sched_barrier(0);
            }
        }
}


constexpr int L_NORMX = 131088;
__device__ __forceinline__ void gate_norm_epi(const Params& p, const Unit& u, const f32x4 (&acc)[2][2][4][2], bool hgrn, int j, LAS unsigned char* lds) {
    int tidx = threadIdx.x; asm volatile("" : "+v"(tidx));
    const int lane = tidx & 63, wid = __builtin_amdgcn_readfirstlane(tidx >> 6), wr = wid >> 2, wc = wid & 3, fr = lane & 15, fq = lane >> 4;
    const u16* Of = hgrn ? (const u16*)(g_ext + X_OHF) : (const u16*)((const unsigned char*)p.out + OFF_OAF);
    const u16* Ob = hgrn ? (const u16*)(g_ext + X_OHB) : (const u16*)((const unsigned char*)p.out + OFF_OAB);
    const float* gain = hgrn ? p.hg_g : p.gla_g;
    u16* A1 = (u16*)(p.ws + OFF_A1) + (hgrn ? 1024 : 0);
    LAS float* X = (LAS float*)(lds + L_NORMX);
    const int rloc = wr * 64 + fr, cbase = wc * 32 + 8 * fq;
#pragma unroll
    for (int ai = 0; ai < 2; ++ai)
#pragma unroll
        for (int m = 0; m < 4; ++m) {
            float ss[2];
#pragma unroll
            for (int bj = 0; bj < 2; ++bj) { const size_t idx = (size_t)(u.pm * 256 + rloc + ai * 128 + m * 16) * 1024 + j * 256 + bj * 128 + cbase;
                const u32x4 a = *(const u32x4*)(Of + idx), b = *(const u32x4*)(Ob + idx);
                float fa[8], fb[8]; unpack8(a, fa); unpack8(b, fb);
                float s = 0.f;
#pragma unroll
                for (int e = 0; e < 8; ++e) { const float o = fa[e] + fb[e]; s += o * o; }
                s += __shfl_xor(s, 16); s += __shfl_xor(s, 32);
                ss[bj] = s; }
            asm volatile("" : "+v"(ss[0]), "+v"(ss[1]));
            if (fq == 0) { X[((rloc + ai * 128 + m * 16) * 2 + 0) * 4 + wc] = ss[0]; X[((rloc + ai * 128 + m * 16) * 2 + 1) * 4 + wc] = ss[1]; }
        }
    asm volatile("s_waitcnt lgkmcnt(0)" ::: "memory"); __builtin_amdgcn_s_barrier(); asm volatile("" ::: "memory");
#pragma unroll
    for (int bj = 0; bj < 2; ++bj) {
        const f32x4 g0 = *(const f32x4*)(gain + (hgrn ? 0 : bj * 128) + cbase), g1 = *(const f32x4*)(gain + (hgrn ? 0 : bj * 128) + cbase + 4);
#pragma unroll
        for (int ai = 0; ai < 2; ++ai)
#pragma unroll
            for (int m = 0; m < 4; ++m) { const int rl = rloc + ai * 128 + m * 16;
                const f32x4 x0 = *(const LAS f32x4*)(X + (rl * 2 + 0) * 4), x1 = *(const LAS f32x4*)(X + (rl * 2 + 1) * 4);
                const float t0 = (x0[0] + x0[1]) + (x0[2] + x0[3]), t1 = (x1[0] + x1[1]) + (x1[2] + x1[3]);
                const float rs = hgrn ? rsqrtf((bj ? t1 : t0) * (1.f / 128.f) + 1e-6f) : rsqrtf((t0 + t1) * (1.f / 256.f) + 1e-6f);
                const size_t idx = (size_t)(u.pm * 256 + rl) * 1024 + j * 256 + bj * 128 + cbase;
                const u32x4 a = *(const u32x4*)(Of + idx), b = *(const u32x4*)(Ob + idx);
                float fa[8], fb[8]; unpack8(a, fa); unpack8(b, fb);
                f32x4 r0, r1;
#pragma unroll
                for (int e = 0; e < 4; ++e) { const float ga = acc[ai][bj][m][0][e], gb = acc[ai][bj][m][1][e];
                    r0[e] = (fa[e] + fb[e]) * rs * g0[e] * (ga * sigmoidf_(ga)); r1[e] = (fa[4 + e] + fb[4 + e]) * rs * g1[e] * (gb * sigmoidf_(gb)); }
                asm volatile("" : "+v"(r0), "+v"(r1));
                *(u32x4*)(A1 + (size_t)(u.pm * 256 + rl) * 2048 + j * 256 + bj * 128 + cbase) = pack8(r0, r1); }
    }
    asm volatile("s_waitcnt lgkmcnt(0)" ::: "memory"); __builtin_amdgcn_s_barrier(); asm volatile("" ::: "memory");
}

__device__ __forceinline__ void epilogue(const Params& p, int phase, const Unit& u, const f32x4 (&acc)[2][2][4][2], int wr, int wc, int fr, int fq, LAS unsigned char* lds) {
    unsigned char* ws = p.ws;
    const int rbase = u.pm * 256 + wr * 64 + fr, cbase = wc * 32 + 8 * fq;
    if (phase == 1 || phase == 2) {
        const int pn = u.pn;
        int kind; unsigned char* dbase = ws; size_t doff; int ld = 1024, col0; float scale = 1.f;
        if (pn < 2) { kind = 0; doff = OFF_Q; ld = 512; col0 = pn * 256; scale = 0.08838834764831845f; }
        else if (pn < 4) { kind = 0; doff = OFF_K; ld = 512; col0 = (pn - 2) * 256; }
        else if (pn < 8) { kind = 0; doff = OFF_V; col0 = (pn - 4) * 256; }
        else if (pn < 10) { kind = 5; doff = OFF_EAF; ld = 512; col0 = (pn - 8) * 256; }
        else if (pn < 12) { kind = 6; doff = OFF_EAB; ld = 512; col0 = (pn - 10) * 256; }
        else if (pn < 16) { kind = 1; doff = OFF_HQ; col0 = (pn - 12) * 256; scale = 0.08838834764831845f; }
        else if (pn < 20) { kind = 3; doff = OFF_EF; col0 = (pn - 16) * 256; }
        else if (pn < 24) { kind = 4; dbase = g_ext; doff = X_EB; col0 = (pn - 20) * 256; }
        else if (pn < 28) { kind = 0; doff = OFF_HV; col0 = (pn - 24) * 256; }
        else if (pn < 32) { gate_norm_epi(p, u, acc, false, pn - 28, lds); return; }
        else if (pn < 36) { gate_norm_epi(p, u, acc, true, pn - 32, lds); return; }
        else if (pn < 40) { kind = 2; doff = OFF_MG; col0 = (pn - 36) * 256; }
        else { kind = 2; doff = OFF_MH; col0 = (pn - 40) * 256; }
        u16* D = (u16*)(dbase + doff);
        if (kind == 0) {
#pragma unroll
            for (int ai = 0; ai < 2; ++ai)
#pragma unroll
                for (int m = 0; m < 4; ++m)
#pragma unroll
                    for (int bj = 0; bj < 2; ++bj) { u16* dst = D + (size_t)(rbase + ai * 128 + m * 16) * ld + col0 + bj * 128 + cbase;
                        *(u32x4*)dst = pack8(acc[ai][bj][m][0] * scale, acc[ai][bj][m][1] * scale); }
        } else if (kind == 1) {
#pragma unroll
            for (int ai = 0; ai < 2; ++ai)
#pragma unroll
                for (int m = 0; m < 4; ++m)
#pragma unroll
                    for (int bj = 0; bj < 2; ++bj) { u16* dst = D + (size_t)(rbase + ai * 128 + m * 16) * ld + col0 + bj * 128 + cbase;
                        f32x4 a = acc[ai][bj][m][0], b = acc[ai][bj][m][1];
#pragma unroll
                        for (int e = 0; e < 4; ++e) { a[e] = a[e] * sigmoidf_(a[e]) * scale; b[e] = b[e] * sigmoidf_(b[e]) * scale; }
                        *(u32x4*)dst = pack8(a, b); }
        } else if (kind == 2) {
#pragma unroll
            for (int ai = 0; ai < 2; ++ai)
#pragma unroll
                for (int m = 0; m < 4; ++m)
#pragma unroll
                    for (int bj = 0; bj < 2; ++bj) { u16* dst = D + (size_t)(rbase + ai * 128 + m * 16) * ld + col0 + bj * 128 + cbase;
                        f32x4 a = acc[ai][bj][m][0], b = acc[ai][bj][m][1];
#pragma unroll
                        for (int e = 0; e < 4; ++e) { a[e] = sigmoidf_(a[e]); b[e] = sigmoidf_(b[e]); }
                        *(u32x4*)dst = pack8(a, b); }
        } else {
            u16* D2 = (u16*)(g_ext + ((kind == 4) ? X_KEB : X_KEF));
            const float* lbp = (const float*)(ws + OFF_LB);
            if (kind == 3) decay_epi<true, false>(acc, D, D2, lbp, ld, col0, rbase, cbase);
            else if (kind == 4) decay_epi<true, true>(acc, D, D2, lbp + 1024, ld, col0, rbase, cbase);
            else if (kind == 5) decay_epi<false, false>(acc, D, D2, p.bias_f, ld, col0, rbase, cbase);
            else decay_epi<false, true>(acc, D, D2, p.bias_b, ld, col0, rbase, cbase);
        }
    } else if (phase == 4) {
        const int g = u.pn >> 2, j = u.pn & 3;
        const u16* Gt = (const u16*)(ws + (g ? OFF_MH : OFF_MG));
        u16* Y = (u16*)(g_ext + X_Y);
#pragma unroll
        for (int ai = 0; ai < 2; ++ai)
#pragma unroll
            for (int m = 0; m < 4; ++m)
#pragma unroll
                for (int bj = 0; bj < 2; ++bj) { const size_t idx = (size_t)(rbase + ai * 128 + m * 16) * 1024 + j * 256 + bj * 128 + cbase;
                    const u32x4 gw = *(const u32x4*)(Gt + idx);
                    f32x4 a = acc[ai][bj][m][0], b = acc[ai][bj][m][1];
                    a[0] *= bflo(gw.x); a[1] *= bfhi(gw.x); a[2] *= bflo(gw.y); a[3] *= bfhi(gw.y);
                    b[0] *= bflo(gw.z); b[1] *= bfhi(gw.z); b[2] *= bflo(gw.w); b[3] *= bfhi(gw.w);
                    if (g) { const u32x4 yw = *(const u32x4*)(Y + idx);
                        a[0] += bflo(yw.x); a[1] += bfhi(yw.x); a[2] += bflo(yw.y); a[3] += bfhi(yw.y);
                        b[0] += bflo(yw.z); b[1] += bfhi(yw.z); b[2] += bflo(yw.w); b[3] += bfhi(yw.w); }
                    *(u32x4*)(Y + idx) = pack8(a, b); }
    } else {
        const float alpha = 1.189207115002721f;
#pragma unroll
        for (int ai = 0; ai < 2; ++ai)
#pragma unroll
            for (int m = 0; m < 4; ++m)
#pragma unroll
                for (int bj = 0; bj < 2; ++bj) { const size_t idx = (size_t)(rbase + ai * 128 + m * 16) * 1024 + u.pn * 256 + bj * 128 + cbase;
                    const f32x4 x0 = *(const f32x4*)(p.x + idx), x1 = *(const f32x4*)(p.x + idx + 4);
                    *(f32x4*)(p.out + idx) = acc[ai][bj][m][0] + alpha * x0; *(f32x4*)(p.out + idx + 4) = acc[ai][bj][m][1] + alpha * x1; }
    }
}

constexpr size_t OFF_XBUF = 61 * MiB + 64 * 1024;
constexpr int LN_CNT_WORD0 = XCD_BAR_WORDS + 1024;
__device__ __forceinline__ void ln_epilogue(const Params& p, const Unit& u, f32x4 (&v)[2][2][4][2], int, int, int, int, LAS unsigned char* lds, int, int) {
    int tidx = threadIdx.x; asm volatile("" : "+v"(tidx));
    const int lane = tidx & 63, wid = __builtin_amdgcn_readfirstlane(tidx >> 6), wr = wid >> 2, wc = wid & 3, fr = lane & 15, fq = lane >> 4;
    LAS f32x2* P = (LAS f32x2*)lds;
    LAS f32x2* S = (LAS f32x2*)(lds + 8192);
    unsigned long long* xbuf = (unsigned long long*)(p.ws + OFF_XBUF);
    unsigned* cnt = (unsigned*)(p.ws + OFF_BAR) + LN_CNT_WORD0 + 64 * u.pm;
    const float alpha = 1.189207115002721f;
    const int rbase = u.pm * 256 + wr * 64 + fr, cbase = u.pn * 256 + wc * 32 + 8 * fq;
#pragma unroll
    for (int ai = 0; ai < 2; ++ai)
#pragma unroll
        for (int m = 0; m < 4; ++m)
#pragma unroll
            for (int bj = 0; bj < 2; ++bj) { const size_t idx = (size_t)(rbase + ai * 128 + m * 16) * 1024 + cbase + bj * 128;
                const f32x4 x0 = *(const f32x4*)(p.x + idx), x1 = *(const f32x4*)(p.x + idx + 4);
                v[ai][bj][m][0] += alpha * x0; v[ai][bj][m][1] += alpha * x1;
                asm volatile("" : "+v"(v[ai][bj][m][0]), "+v"(v[ai][bj][m][1]));
            }
#pragma unroll
    for (int ai = 0; ai < 2; ++ai)
#pragma unroll
        for (int m = 0; m < 4; ++m) {
            float s = 0.f;
#pragma unroll
            for (int bj = 0; bj < 2; ++bj)
#pragma unroll
                for (int n = 0; n < 2; ++n) { const f32x4 x = v[ai][bj][m][n]; s += (x[0] + x[1]) + (x[2] + x[3]); }
            s += __shfl_xor(s, 16); s += __shfl_xor(s, 32);
            const float mw = s * (1.0f / 64.0f); float q = 0.f;
#pragma unroll
            for (int bj = 0; bj < 2; ++bj)
#pragma unroll
                for (int n = 0; n < 2; ++n) { const f32x4 d = v[ai][bj][m][n] - mw; q += (d[0] * d[0] + d[1] * d[1]) + (d[2] * d[2] + d[3] * d[3]); }
            q += __shfl_xor(q, 16); q += __shfl_xor(q, 32);
            if (fq == 0) P[(ai * 128 + wr * 64 + m * 16 + fr) * 4 + wc] = (f32x2){mw, q};
        }
    __syncthreads();
    const int row = wid * 32 + (lane & 31);
    if (lane < 32) {
        const f32x2 a = P[row * 4 + 0], b = P[row * 4 + 1], c = P[row * 4 + 2], d = P[row * 4 + 3];
        const float mt = (a.x + b.x + c.x + d.x) * 0.25f;
        const float da = a.x - mt, db = b.x - mt, dc = c.x - mt, dd = d.x - mt;
        const float m2 = (a.y + b.y) + (c.y + d.y) + 64.0f * ((da * da + db * db) + (dc * dc + dd * dd));
        unsigned long long* slot = xbuf + ((size_t)(u.pm * 256 + row) * 4 + u.pn);
        __hip_atomic_store(slot, ((unsigned long long)__float_as_uint(m2) << 32) | __float_as_uint(mt), __ATOMIC_RELAXED, __HIP_MEMORY_SCOPE_AGENT);
    }
    asm volatile("s_waitcnt vmcnt(0)" ::: "memory");
    if (lane == 0) __hip_atomic_fetch_add(cnt, 1u, __ATOMIC_RELAXED, __HIP_MEMORY_SCOPE_AGENT);
    if (wid == 0) {
        unsigned sp = 0;
        while ((unsigned)__builtin_amdgcn_readfirstlane(__hip_atomic_load(cnt, __ATOMIC_RELAXED, __HIP_MEMORY_SCOPE_AGENT)) < 32u) { __builtin_amdgcn_s_sleep(2); if (++sp > (1u << 20)) break; }
        __builtin_amdgcn_fence(__ATOMIC_ACQUIRE, "agent");
    }
    asm volatile("s_waitcnt vmcnt(0) lgkmcnt(0)" ::: "memory");
    __syncthreads();
    if (lane < 32) {
        const unsigned long long* slot = xbuf + (size_t)(u.pm * 256 + row) * 4; float mt[4], m2[4]; float ms = 0.f;
#pragma unroll
        for (int t = 0; t < 4; ++t) { const unsigned long long w = __hip_atomic_load(slot + t, __ATOMIC_RELAXED, __HIP_MEMORY_SCOPE_AGENT); mt[t] = __uint_as_float((unsigned)w); m2[t] = __uint_as_float((unsigned)(w >> 32)); ms += mt[t]; }
        const float mean = ms * 0.25f; float q = 0.f;
#pragma unroll
        for (int t = 0; t < 4; ++t) { const float dm = mt[t] - mean; q += m2[t] + 256.0f * dm * dm; }
        S[row] = (f32x2){mean, 1.0f / sqrtf(q * (1.0f / 1024.0f) + 1e-5f)};
    }
    __syncthreads();
#pragma unroll
    for (int bj = 0; bj < 2; ++bj) {
        const f32x4 g0 = *(const f32x4*)(p.ln_g + cbase + bj * 128), g1 = *(const f32x4*)(p.ln_g + cbase + bj * 128 + 4);
        const f32x4 b0 = *(const f32x4*)(p.ln_b + cbase + bj * 128), b1 = *(const f32x4*)(p.ln_b + cbase + bj * 128 + 4);
#pragma unroll
        for (int ai = 0; ai < 2; ++ai)
#pragma unroll
            for (int m = 0; m < 4; ++m) { const int rl = ai * 128 + wr * 64 + m * 16 + fr; const f32x2 st = S[rl];
                const size_t idx = (size_t)(u.pm * 256 + rl) * 1024 + cbase + bj * 128;
                *(f32x4*)(p.out + idx) = (v[ai][bj][m][0] - st.x) * st.y * g0 + b0;
                *(f32x4*)(p.out + idx + 4) = (v[ai][bj][m][1] - st.x) * st.y * g1 + b1; }
    }
}

__device__ __forceinline__ void gemm_phase(const Params& p, LAS unsigned char* lds, const Sched& S, int lda, int ldb, int K) {
    int tid = threadIdx.x; asm volatile("" : "+v"(tid));
    const int wid = __builtin_amdgcn_readfirstlane(tid >> 6), lane = tid & 63, wr = wid >> 2, wc = wid & 3, fr = lane & 15, fq = lane >> 4;
    const int nt = K / BK;
    unsigned voffA[2], voffB[2];
#pragma unroll
    for (int i = 0; i < 2; ++i) { int R, C; stage_rc(tid * 16 + i * 8192, R, C); const int Rb = (R & ~31) + perm32(R & 31);
        voffA[i] = (unsigned)(R * lda + C) * 2u; voffB[i] = (unsigned)(Rb * ldb + C) * 2u; }
    const size_t kstep = (size_t)(BK * 2);
    const size_t hstepA = (size_t)HALF * lda * 2, hstepB = (size_t)HALF * ldb * 2;
    const unsigned ldsw = (unsigned)wid * 1024u;
    const int aoff = lds_byte(wr * 64 + fr, fq * 8), boff = lds_byte(wc * 32 + fr, fq * 8);
#define G_SA(b, h) (((b) * 2 + (h)) * HTB)
#define G_SB(b, h) ((4 + (b) * 2 + (h)) * HTB)
#define G_STAGE(bufoff, gbase, voff) do { _Pragma("unroll") for (int _i = 0; _i < 2; ++_i) \
        __builtin_amdgcn_global_load_lds((const unsigned*)((const char*)(gbase) + (voff)[_i]), (LAS unsigned*)(lds + (bufoff) + ldsw + _i * 8192), 16, 0, 0); } while (0)
#define G_LDA(dst, b, h) do { _Pragma("unroll") for (int m = 0; m < 4; ++m) _Pragma("unroll") for (int k = 0; k < 2; ++k) dst[m][k] = *(const LAS bf16x8*)(lds + G_SA(b, h) + aoff + m * 2048 + k * 1024); } while (0)
#define G_LDB(dst, b, h) do { _Pragma("unroll") for (int n = 0; n < 2; ++n) _Pragma("unroll") for (int k = 0; k < 2; ++k) dst[n][k] = *(const LAS bf16x8*)(lds + G_SB(b, h) + boff + n * 2048 + k * 1024); } while (0)
#define G_MMA(ai, bj, At, Bt) do { __builtin_amdgcn_s_setprio(1); _Pragma("unroll") for (int m = 0; m < 4; ++m) _Pragma("unroll") for (int n = 0; n < 2; ++n) _Pragma("unroll") for (int k = 0; k < 2; ++k) \
        acc[ai][bj][m][n] = __builtin_amdgcn_mfma_f32_16x16x32_bf16(Bt[n][k], At[m][k], acc[ai][bj][m][n], 0, 0, 0); __builtin_amdgcn_s_setprio(0); } while (0)
#define G_WAIT_V(n) asm volatile("s_waitcnt vmcnt(" #n ")" ::: "memory")
#define G_WAIT_L(n) asm volatile("s_waitcnt lgkmcnt(" #n ")" ::: "memory")
#define G_BAR __builtin_amdgcn_s_barrier()
#define G_SCHED __builtin_amdgcn_sched_barrier(0)
    Unit cur, nxt; int ui = 0;
    if (!S.next(0, cur)) return;
    f32x4 acc[2][2][4][2];
#pragma unroll
    for (int a = 0; a < 2; ++a)
#pragma unroll
        for (int b = 0; b < 2; ++b)
#pragma unroll
            for (int m = 0; m < 4; ++m)
#pragma unroll
                for (int n = 0; n < 2; ++n) acc[a][b][m][n] = (f32x4){0.f, 0.f, 0.f, 0.f};
    bf16x8 At[4][2], B0[2][2], B1[2][2];
    const char* cA = cur.a; const char* cB = cur.b;
    G_STAGE(G_SB(0, 0), cB, voffB); G_STAGE(G_SB(0, 1), cB + hstepB, voffB); G_STAGE(G_SA(0, 0), cA, voffA); G_STAGE(G_SA(0, 1), cA + hstepA, voffA);
    if (wr == 1) G_BAR;
    G_WAIT_V(2); G_BAR;
    G_STAGE(G_SB(1, 0), cB + kstep, voffB); G_STAGE(G_SA(1, 0), cA + kstep, voffA); G_STAGE(G_SB(1, 1), cB + hstepB + kstep, voffB);
    G_WAIT_V(6); G_BAR;
    for (;;) {
        const bool has_next = S.next(ui + 1, nxt);
        const char* nA = has_next ? nxt.a : cA; const char* nB = has_next ? nxt.b : cB;
        for (int t = 0; t < nt; t += 2) {
            const bool last = (t == nt - 2);
            const char* a1 = cA + (size_t)(t + 1) * kstep;
            const char* a2 = last ? nA : cA + (size_t)(t + 2) * kstep; const char* b2 = last ? nB : cB + (size_t)(t + 2) * kstep;
            const char* a3 = a2 + kstep; const char* b3 = b2 + kstep;
            G_LDB(B0, 0, 0); G_LDB(B1, 0, 1); G_SCHED; G_LDA(At, 0, 0); G_STAGE(G_SA(1, 1), a1 + hstepA, voffA);
            G_WAIT_V(8); G_WAIT_L(0); G_BAR; G_MMA(0, 0, At, B0); G_MMA(0, 1, At, B1); G_BAR; G_SCHED;
            G_LDA(At, 0, 1); G_STAGE(G_SB(0, 0), b2, voffB); G_STAGE(G_SB(0, 1), b2 + hstepB, voffB); G_STAGE(G_SA(0, 0), a2, voffA);
            G_WAIT_V(8); G_WAIT_L(0); G_BAR; G_MMA(1, 0, At, B0); G_MMA(1, 1, At, B1); G_BAR; G_SCHED;
            G_LDB(B0, 1, 0); G_LDB(B1, 1, 1); G_SCHED; G_LDA(At, 1, 0); G_STAGE(G_SA(0, 1), a2 + hstepA, voffA);
            G_WAIT_V(8); G_WAIT_L(0); G_BAR; G_MMA(0, 0, At, B0); G_MMA(0, 1, At, B1); G_BAR; G_SCHED;
            G_LDA(At, 1, 1); G_STAGE(G_SB(1, 0), b3, voffB); G_STAGE(G_SB(1, 1), b3 + hstepB, voffB); G_STAGE(G_SA(1, 0), a3, voffA);
            G_WAIT_V(8); G_WAIT_L(0); G_BAR; G_MMA(1, 0, At, B0); G_MMA(1, 1, At, B1); G_BAR; G_SCHED;
        }
        if (wr == 0) G_BAR;
        if (S.phase != 5) epilogue(p, S.phase, cur, acc, wr, wc, fr, fq, lds);
        if (!has_next) break;
#pragma unroll
        for (int a = 0; a < 2; ++a)
#pragma unroll
            for (int b = 0; b < 2; ++b)
#pragma unroll
                for (int m = 0; m < 4; ++m)
#pragma unroll
                    for (int n = 0; n < 2; ++n) acc[a][b][m][n] = (f32x4){0.f, 0.f, 0.f, 0.f};
        cur = nxt; cA = nA; cB = nB; ++ui;
        if (wr == 1) G_BAR;
    }
    G_WAIT_V(0);
    G_BAR;
    if (S.phase == 5) ln_epilogue(p, cur, acc, wr, wc, fr, fq, lds, wid, lane);
}

__device__ __forceinline__ void phase0(const Params& p, LAS unsigned char* lds) {
    const int tid = threadIdx.x;
    const size_t gtid = (size_t)blockIdx.x * 512 + tid, gsz = (size_t)gridDim.x * 512;
    {
        const f32x4* x4 = (const f32x4*)p.x; u32x4* xb = (u32x4*)(p.ws + OFF_XB);
        const size_t n8 = (size_t)MTOK * DM / 8;
        for (size_t i = gtid; i < n8; i += gsz) { const f32x4 a = x4[2 * i], b = x4[2 * i + 1]; xb[i] = pack8(a, b); }
    }
    if (gtid < 2048) {
        const int d = (int)gtid & 1023; const float* L = (gtid < 1024) ? p.lbl_f : p.lbl_b;
        const float l0 = L[d], l1 = L[1024 + d];
        ((float*)(p.ws + OFF_LB))[gtid] = 1.f / (1.f + expf(l1 - l0));
    }
    LAS float* T = (LAS float*)lds;
    for (int job = blockIdx.x; job < 1408 + 384; job += gridDim.x) {
        const float* src; u16* dst; int ldw, nt64, kt, isin;
        if (job < 1408) { isin = 1; src = p.w_in; ldw = NIN; dst = (u16*)(p.ws + OFF_WINT); nt64 = job >> 3; kt = job & 7; }
        else { const int jj = job - 1408, mat = jj >> 7, r = jj & 127; isin = 0; ldw = 1024; nt64 = r >> 3; kt = r & 7;
            src = mat == 0 ? p.w_gla : (mat == 1 ? p.w_hgrn : p.w_out); dst = (u16*)(p.ws + (mat == 0 ? OFF_WGT : (mat == 1 ? OFF_WHT : OFF_WOT))); }
        const int c = tid & 63, kr = tid >> 6;
        const int m = nt64 * 64 + c;
        int orig = m; int eff = 0;
        if (isin) {
            if (m < 2048) orig = m;
            else if (m < 3072) { eff = 1; orig = m - 2048; }
            else if (m < 7168) orig = m + 32;
            else if (m < 8192) orig = 2048 + (m - 7168);
            else orig = 7200 + (m - 8192);
        }
        if (eff) {
            const int bw = orig >> 9, cc = orig & 511;
            const float* U = bw ? p.up_b : p.up_f;
            float uv[16];
#pragma unroll
            for (int r = 0; r < 16; ++r) uv[r] = U[r * 512 + cc];
            for (int i = 0; i < 16; ++i) { const int k = kr + 8 * i;
                const float* wr_ = src + (size_t)(kt * 128 + k) * ldw + 3072 + bw * 16;
                float s = 0.f;
#pragma unroll
                for (int r = 0; r < 16; ++r) s += wr_[r] * uv[r];
                T[k * 65 + c] = s; }
        } else {
#pragma unroll 4
            for (int i = 0; i < 16; ++i) { const int k = kr + 8 * i;
                T[k * 65 + c] = src[(size_t)(kt * 128 + k) * ldw + orig]; }
        }
        __syncthreads();
        const int rho = tid >> 3, kseg = tid & 7;
        float v[16];
#pragma unroll
        for (int kk = 0; kk < 16; ++kk) v[kk] = T[(kseg * 16 + kk) * 65 + rho];
        u32x4 w0, w1;
        w0.x = pk_bf16(v[0], v[1]); w0.y = pk_bf16(v[2], v[3]); w0.z = pk_bf16(v[4], v[5]); w0.w = pk_bf16(v[6], v[7]);
        w1.x = pk_bf16(v[8], v[9]); w1.y = pk_bf16(v[10], v[11]); w1.z = pk_bf16(v[12], v[13]); w1.w = pk_bf16(v[14], v[15]);
        u16* d = dst + (size_t)(nt64 * 64 + rho) * 1024 + kt * 128 + kseg * 16;
        *(u32x4*)d = w0; *(u32x4*)(d + 8) = w1;
        __syncthreads();
    }
}

constexpr int S_QE = 0, S_KE = 19456, S_V = 38912, S_PP = 48128, S_ST0 = 57344, S_ST1 = 76800, S_DEC = 96256;
constexpr int RS = 304, RV = 144;
typedef short s16x4 __attribute__((ext_vector_type(4)));
#define MFMA16(a, b, c) __builtin_amdgcn_mfma_f32_16x16x32_bf16(a, b, c, 0, 0, 0)

__device__ __forceinline__ bf16x8 tr8(LAS unsigned char* p0, int stride4) {
    const s16x4 a = __builtin_amdgcn_ds_read_tr16_b64_v4i16((LAS s16x4*)p0);
    const s16x4 b = __builtin_amdgcn_ds_read_tr16_b64_v4i16((LAS s16x4*)(p0 + stride4));
    return __builtin_shufflevector(a, b, 0, 1, 2, 3, 4, 5, 6, 7);
}

__device__ __forceinline__ void scan_phase(const Params& p, LAS unsigned char* lds) {
    const int tid = threadIdx.x, w = __builtin_amdgcn_readfirstlane(tid >> 6), lane = tid & 63, fr = lane & 15, fq = lane >> 4;
    const int ti = tid >> 3, ch = tid & 7;
    for (int u = blockIdx.x; u < 256; u += gridDim.x) {
        const int xcd = u & 7, slot = u >> 3;
        const bool isg = slot < 16;
        int bb, hh, dir, e0, ldq;
        const u16 *Qp, *Ep, *Kp, *Vp; u16* Op;
        if (isg) { const int grp = xcd + 8 * (slot >> 2), sl = slot & 3; bb = grp >> 3; hh = (grp >> 1) & 3; dir = grp & 1; e0 = hh * 256 + sl * 64; ldq = 512;
            Qp = (const u16*)(p.ws + OFF_Q); Kp = (const u16*)(p.ws + OFF_K); Ep = (const u16*)(p.ws + (dir ? OFF_EAB : OFF_EAF)); Vp = (const u16*)(p.ws + OFF_V);
            Op = (u16*)((unsigned char*)p.out + (dir ? OFF_OAB : OFF_OAF)); }
        else { const int s = slot - 16, grp = xcd + 8 * (s >> 1), sl = s & 1; bb = grp >> 4; hh = (grp >> 1) & 7; dir = grp & 1; e0 = hh * 128 + sl * 64; ldq = 1024;
            Qp = (const u16*)(p.ws + OFF_HQ); Vp = (const u16*)(p.ws + OFF_HV);
            Ep = dir ? (const u16*)(g_ext + X_EB) : (const u16*)(p.ws + OFF_EF); Kp = (const u16*)(g_ext + (dir ? X_KEB : X_KEF));
            Op = (u16*)(g_ext + (dir ? X_OHB : X_OHF)); }
        const int qc = hh * 128 + ch * 16;
        const int tb = bb * SEQ, sgn = dir ? -1 : 1;
        for (int i = tid; i < 19456 / 4; i += 512) *(LAS unsigned*)(lds + S_ST0 + i * 4) = 0u;
        f32x4 sacc[4];
#pragma unroll
        for (int ne = 0; ne < 4; ++ne) sacc[ne] = (f32x4){0.f, 0.f, 0.f, 0.f};
        u32x4 rq[2], re[2], rk[2], rv;
        {
            const size_t t = (size_t)(tb + (dir ? SEQ - 1 : 0) + sgn * ti);
            rq[0] = *(const u32x4*)(Qp + t * ldq + qc); rq[1] = *(const u32x4*)(Qp + t * ldq + qc + 8);
            re[0] = *(const u32x4*)(Ep + t * ldq + qc); re[1] = *(const u32x4*)(Ep + t * ldq + qc + 8);
            rk[0] = *(const u32x4*)(Kp + t * ldq + qc); rk[1] = *(const u32x4*)(Kp + t * ldq + qc + 8);
            rv = *(const u32x4*)(Vp + t * 1024 + e0 + ch * 8);
        }
        __syncthreads();
        for (int c = 0; c < 64; ++c) {
            const int base = tb + (dir ? SEQ - 1 - 64 * c : 64 * c);
#pragma unroll
            for (int hf = 0; hf < 2; ++hf) {
                float q[8], e[8];
                unpack8(rq[hf], q); unpack8(re[hf], e);
                f32x4 a0, a1;
#pragma unroll
                for (int x = 0; x < 4; ++x) { a0[x] = q[x] * e[x]; a1[x] = q[4 + x] * e[4 + x]; }
                *(LAS u32x4*)(lds + S_QE + ti * RS + ch * 32 + hf * 16) = pack8(a0, a1);
                if (isg) { float k[8]; unpack8(rk[hf], k);
#pragma unroll
                    for (int x = 0; x < 4; ++x) { a0[x] = k[x] * __builtin_amdgcn_rcpf(e[x]); a1[x] = k[4 + x] * __builtin_amdgcn_rcpf(e[4 + x]); }
                    *(LAS u32x4*)(lds + S_KE + ti * RS + ch * 32 + hf * 16) = pack8(a0, a1); }
                else *(LAS u32x4*)(lds + S_KE + ti * RS + ch * 32 + hf * 16) = rk[hf];
                if (ti == 63) { *(LAS f32x4*)(lds + S_DEC + (ch * 16 + hf * 8) * 4) = (f32x4){e[0], e[1], e[2], e[3]}; *(LAS f32x4*)(lds + S_DEC + (ch * 16 + hf * 8 + 4) * 4) = (f32x4){e[4], e[5], e[6], e[7]}; }
            }
            *(LAS u32x4*)(lds + S_V + ti * RV + ch * 16) = rv;
            if (c < 63) {
                const size_t t = (size_t)(tb + (dir ? SEQ - 1 - 64 * (c + 1) : 64 * (c + 1)) + sgn * ti);
                rq[0] = *(const u32x4*)(Qp + t * ldq + qc); rq[1] = *(const u32x4*)(Qp + t * ldq + qc + 8);
                re[0] = *(const u32x4*)(Ep + t * ldq + qc); re[1] = *(const u32x4*)(Ep + t * ldq + qc + 8);
                rk[0] = *(const u32x4*)(Kp + t * ldq + qc); rk[1] = *(const u32x4*)(Kp + t * ldq + qc + 8);
                rv = *(const u32x4*)(Vp + t * 1024 + e0 + ch * 8);
            }
            __syncthreads();
            {
                const int mi = w >> 1, njb = (w & 1) * 2;
                f32x4 sc[2]; sc[0] = (f32x4){0.f, 0.f, 0.f, 0.f}; sc[1] = sc[0];
#pragma unroll
                for (int kk = 0; kk < 4; ++kk) { const bf16x8 bq = *(const LAS bf16x8*)(lds + S_QE + (16 * mi + fr) * RS + (32 * kk + 8 * fq) * 2);
#pragma unroll
                    for (int n2 = 0; n2 < 2; ++n2) { const bf16x8 ak = *(const LAS bf16x8*)(lds + S_KE + (16 * (njb + n2) + fr) * RS + (32 * kk + 8 * fq) * 2); sc[n2] = MFMA16(ak, bq, sc[n2]); } }
                const int i = 16 * mi + fr;
#pragma unroll
                for (int n2 = 0; n2 < 2; ++n2) { const int j0 = 16 * (njb + n2) + 4 * fq;
                    const float m0 = (i >= j0) ? sc[n2][0] : 0.f, m1 = (i >= j0 + 1) ? sc[n2][1] : 0.f, m2 = (i >= j0 + 2) ? sc[n2][2] : 0.f, m3 = (i >= j0 + 3) ? sc[n2][3] : 0.f;
                    *(LAS u32x2*)(lds + S_PP + i * RV + j0 * 2) = (u32x2){pk_bf16(m0, m1), pk_bf16(m2, m3)}; }
            }
            const int stold = (c & 1) ? S_ST1 : S_ST0, stnew = (c & 1) ? S_ST0 : S_ST1;
            {
#pragma unroll
                for (int kk = 0; kk < 2; ++kk) {
                    const int jr = 32 * kk + 8 * fq + (fr >> 2);
                    const bf16x8 a = tr8(lds + S_KE + jr * RS + (16 * w + 4 * (fr & 3)) * 2, 4 * RS);
#pragma unroll
                    for (int ne = 0; ne < 4; ++ne) { const bf16x8 bv = tr8(lds + S_V + jr * RV + (16 * ne + 4 * (fr & 3)) * 2, 4 * RV); sacc[ne] = MFMA16(a, bv, sacc[ne]); } }
                const f32x4 dec = *(const LAS f32x4*)(lds + S_DEC + (16 * w + 4 * fq) * 4);
#pragma unroll
                for (int ne = 0; ne < 4; ++ne) { sacc[ne] = sacc[ne] * dec;
                    *(LAS u32x2*)(lds + stnew + (16 * ne + fr) * RS + (16 * w + 4 * fq) * 2) = (u32x2){pk_bf16(sacc[ne][0], sacc[ne][1]), pk_bf16(sacc[ne][2], sacc[ne][3])}; }
            }
            __syncthreads();
            {
                const int mi = w >> 1, neb = (w & 1) * 2;
                f32x4 oa[2]; oa[0] = (f32x4){0.f, 0.f, 0.f, 0.f}; oa[1] = oa[0];
#pragma unroll
                for (int kk = 0; kk < 4; ++kk) { const bf16x8 b = *(const LAS bf16x8*)(lds + S_QE + (16 * mi + fr) * RS + (32 * kk + 8 * fq) * 2);
#pragma unroll
                    for (int n2 = 0; n2 < 2; ++n2) { const bf16x8 a = *(const LAS bf16x8*)(lds + stold + (16 * (neb + n2) + fr) * RS + (32 * kk + 8 * fq) * 2); oa[n2] = MFMA16(a, b, oa[n2]); } }
#pragma unroll
                for (int kk = 0; kk < 2; ++kk) { const bf16x8 b = *(const LAS bf16x8*)(lds + S_PP + (16 * mi + fr) * RV + (32 * kk + 8 * fq) * 2);
                    const int jr = 32 * kk + 8 * fq + (fr >> 2);
#pragma unroll
                    for (int n2 = 0; n2 < 2; ++n2) { const bf16x8 a = tr8(lds + S_V + jr * RV + (16 * (neb + n2) + 4 * (fr & 3)) * 2, 4 * RV); oa[n2] = MFMA16(a, b, oa[n2]); } }
                u16* optr = Op + (size_t)(base + sgn * (16 * mi + fr)) * 1024 + e0 + 16 * neb + 4 * fq;
                *(u32x2*)optr = (u32x2){pk_bf16(oa[0][0], oa[0][1]), pk_bf16(oa[0][2], oa[0][3])};
                *(u32x2*)(optr + 16) = (u32x2){pk_bf16(oa[1][0], oa[1][1]), pk_bf16(oa[1][2], oa[1][3])};
            }
            __syncthreads();
        }
    }
}

#define XB_TMO      128
#define XB_XCNT(j)  (256  + 64 * (j))
#define XB_XSUB(j)  (1280 + 64 * (j))
#define XB_XGEN(j)  (2304 + 64 * (j))
#define XB_TOP      3328
#define XB_TOPGEN   3392
#define XB_SPIN_CAP (1u << 18)
__device__ __forceinline__ unsigned xb_ld(unsigned* p)              { return __hip_atomic_load(p, __ATOMIC_RELAXED, __HIP_MEMORY_SCOPE_AGENT); }
__device__ __forceinline__ unsigned xb_add(unsigned* p, unsigned v) { return __hip_atomic_fetch_add(p, v, __ATOMIC_RELAXED, __HIP_MEMORY_SCOPE_AGENT); }
__device__ __forceinline__ unsigned xb_xcc_id() { return (unsigned)__builtin_amdgcn_s_getreg((3 << 11) | 20) & 0xFu; }
#define XB_SPIN(cond, bar) do { unsigned _sp = 0; while (cond) { __builtin_amdgcn_s_sleep(1); \
    if ((++_sp & 255u) == 0u) { if (xb_ld(&(bar)[XB_TMO])) break; if (_sp > XB_SPIN_CAP) { atomicAdd(&(bar)[XB_TMO], 1u); break; } } } } while (0)
struct XcdBarrier { unsigned* bar; unsigned x; volatile LAS unsigned* st; };
__device__ __forceinline__ XcdBarrier xcd_barrier_post(unsigned* bar, volatile LAS unsigned* st) {
    XcdBarrier b; b.bar = bar; b.x = xb_xcc_id(); b.st = st;
    if (threadIdx.x == 0) (void)xb_add(&bar[XB_XCNT(b.x)], 1u);
    return b;
}
__device__ __forceinline__ void xcd_barrier_complete(unsigned* bar, unsigned x, unsigned& nloc, unsigned& nx) {
    const unsigned G = gridDim.x * gridDim.y * gridDim.z;
    unsigned sum, cnt, mine, sp = 0u;
    for (;;) {
        sum = 0u; cnt = 0u; mine = 0u;
#pragma unroll
        for (unsigned j = 0; j < 16; ++j) { const unsigned c = xb_ld(&bar[XB_XCNT(j)]); sum += c; cnt += (c > 0u) ? 1u : 0u; mine = (j == x) ? c : mine; }
        if (sum == G) break;
        __builtin_amdgcn_s_sleep(1);
        if ((++sp & 255u) == 0u) { if (xb_ld(&bar[XB_TMO])) break; if (sp > XB_SPIN_CAP) { atomicAdd(&bar[XB_TMO], 1u); break; } }
    }
    nloc = mine > 0u ? mine : 1u; nx = cnt > 0u ? cnt : 1u;
}
__device__ __forceinline__ void xcd_barrier(const XcdBarrier& b) {
    asm volatile("s_waitcnt vmcnt(0)" ::: "memory");
    __syncthreads();
    if (threadIdx.x == 0) {
        unsigned* bar = b.bar;
        __builtin_amdgcn_s_waitcnt(0);
        unsigned nloc = b.st[0], nx = b.st[1];
        if (nloc == 0u) { xcd_barrier_complete(bar, b.x, nloc, nx); b.st[0] = nloc; b.st[1] = nx; }
        const unsigned old = xb_add(&bar[XB_XSUB(b.x)], 1u);
        const unsigned gen = old / nloc;
        if (old + 1u == (gen + 1u) * nloc) {
            __builtin_amdgcn_fence(__ATOMIC_RELEASE, "agent");
            asm volatile("s_waitcnt vmcnt(0)" ::: "memory");
            const unsigned og = xb_add(&bar[XB_TOP], 1u);
            const unsigned tg = og / nx;
            if (og + 1u == (tg + 1u) * nx) xb_add(&bar[XB_TOPGEN], 1u);
            else XB_SPIN(xb_ld(&bar[XB_TOPGEN]) == tg, bar);
            __builtin_amdgcn_fence(__ATOMIC_ACQUIRE, "agent");
            xb_add(&bar[XB_XGEN(b.x)], 1u);
            asm volatile("s_waitcnt vmcnt(0)" ::: "memory");
        } else {
            XB_SPIN(xb_ld(&bar[XB_XGEN(b.x)]) == gen, bar);
            __builtin_amdgcn_fence(__ATOMIC_ACQUIRE, "agent");
            asm volatile("s_waitcnt vmcnt(0)" ::: "memory");
        }
    }
    __syncthreads();
}

__global__ void __launch_bounds__(512) mega(Params p) {
    extern __shared__ __attribute__((aligned(16))) unsigned char lds_raw[];
    LAS unsigned char* lds = (LAS unsigned char*)lds_raw;
    cg::grid_group grid = cg::this_grid();
    volatile LAS unsigned* xst = (volatile LAS unsigned*)(lds + 131072);
    if (threadIdx.x == 0) { xst[0] = 0u; xst[1] = 0u; xst[2] = 0u; xst[3] = 0u; }
    __syncthreads();
    const XcdBarrier xb = xcd_barrier_post((unsigned*)(p.ws + OFF_BAR), xst);
    Sched S; S.G = gridDim.x; S.c = blockIdx.x; S.ws = p.ws;
    if (p.ws == nullptr) grid.sync();
    phase0(p, lds);
    xcd_barrier(xb);
    S.phase = 1; S.nN = 28; S.ntiles = 64 * 28; S.nsub = 1;
    gemm_phase(p, lds, S, 1024, 1024, 1024);
    xcd_barrier(xb);
    scan_phase(p, lds);
    xcd_barrier(xb);
    S.phase = 2; S.nN = 16; S.ntiles = 64 * 16; S.nsub = 1;
    gemm_phase(p, lds, S, 1024, 1024, 1024);
    xcd_barrier(xb);
    S.phase = 4; S.nN = 4; S.ntiles = 256; S.nsub = 2;
    gemm_phase(p, lds, S, 2048, 1024, 1024);
    xcd_barrier(xb);
    S.phase = 5; S.nN = 4; S.ntiles = 256; S.nsub = 1;
    gemm_phase(p, lds, S, 1024, 1024, 1024);
}

extern "C" void kernel_launch(void* const* d_in, const int* in_sizes, int n_in,
                              void* d_out, int out_size, void* d_ws, size_t ws_size,
                              hipStream_t stream) {
    constexpr size_t kDynLds = 131088 + 8192;
    static int grid_blocks = 0;
    if (!grid_blocks) {
        int dev = 0, cus = 0, per_cu = 0;
        (void)hipGetDevice(&dev);
        (void)hipDeviceGetAttribute(&cus, hipDeviceAttributeMultiprocessorCount, dev);
        (void)hipFuncSetAttribute((const void*)mega, hipFuncAttributeMaxDynamicSharedMemorySize, (int)kDynLds);
        (void)hipOccupancyMaxActiveBlocksPerMultiprocessor(&per_cu, mega, 512, kDynLds);
        if (per_cu < 1) per_cu = 1;
        if (per_cu > 1) per_cu = 1;
        grid_blocks = cus * per_cu;
    }
    Params p{};
    p.x = (const float*)d_in[0]; p.w_in = (const float*)d_in[1]; p.up_f = (const float*)d_in[2]; p.bias_f = (const float*)d_in[3];
    p.up_b = (const float*)d_in[4]; p.bias_b = (const float*)d_in[5]; p.gla_g = (const float*)d_in[6]; p.lbl_f = (const float*)d_in[7];
    p.lbl_b = (const float*)d_in[8]; p.hg_g = (const float*)d_in[9]; p.w_gla = (const float*)d_in[10]; p.w_hgrn = (const float*)d_in[11];
    p.w_out = (const float*)d_in[12]; p.ln_g = (const float*)d_in[13]; p.ln_b = (const float*)d_in[14];
    p.out = (float*)d_out; p.ws = (unsigned char*)d_ws;
    (void)hipMemsetAsync((unsigned char*)d_ws + OFF_BAR, 0, (XCD_BAR_WORDS + 1024 + 64 * 64) * sizeof(unsigned), stream);
    void* args[] = {&p};
    hipError_t e = hipLaunchCooperativeKernel((void*)mega, dim3(grid_blocks), dim3(512), args, kDynLds, stream);
    if (e != hipSuccess) fprintf(stderr, "cooperative launch failed: %s (grid %d)\n", hipGetErrorString(e), grid_blocks);
}
```

```cpp
#include <hip/hip_runtime.h>
#include <hip/hip_cooperative_groups.h>
#include <cstdio>
#include <cstdint>
namespace cg = cooperative_groups;

#define LAS __attribute__((address_space(3)))
typedef unsigned short u16;
typedef short bf16x8 __attribute__((ext_vector_type(8)));
typedef float f32x4 __attribute__((ext_vector_type(4)));
typedef float f32x2 __attribute__((ext_vector_type(2)));
typedef unsigned u32x4 __attribute__((ext_vector_type(4)));
typedef unsigned u32x2 __attribute__((ext_vector_type(2)));
typedef _Float16 h16x2 __attribute__((ext_vector_type(2)));

constexpr int SEQ = 4096, MTOK = 16384, DM = 1024, NIN = 10272;
constexpr size_t MiB = 1024ull * 1024ull;
constexpr size_t OFF_BAR = 61 * MiB;
#define XCD_BAR_WORDS 3456
constexpr size_t OFF_XB = 0, OFF_WINT = 32 * MiB, OFF_WGT = 54 * MiB, OFF_WHT = 56 * MiB, OFF_WOT = 58 * MiB, OFF_LB = 60 * MiB;
constexpr size_t OFF_Q = 64 * MiB, OFF_K = 80 * MiB, OFF_V = 96 * MiB, OFF_EAF = 128 * MiB, OFF_EAB = 144 * MiB, OFF_HQ = 160 * MiB, OFF_HV = 192 * MiB, OFF_EF = 224 * MiB;
constexpr size_t OFF_GATEA = 64 * MiB, OFF_HGATE = 96 * MiB, OFF_MG = 128 * MiB, OFF_MH = 160 * MiB, OFF_A1 = 192 * MiB;
constexpr size_t X_KEF = 0, X_EB = 32 * MiB, X_KEB = 64 * MiB, X_OHF = 96 * MiB, X_OHB = 128 * MiB, X_Y = 0;
__device__ __attribute__((aligned(256))) unsigned char g_ext[160 * MiB];
constexpr size_t OFF_OAF = 0, OFF_OAB = 32 * MiB;

struct Params {
    const float *x, *w_in, *up_f, *bias_f, *up_b, *bias_b, *gla_g, *lbl_f, *lbl_b, *hg_g, *w_gla, *w_hgrn, *w_out, *ln_g, *ln_b;
    float* out;
    unsigned char* ws;
};

typedef __bf16 bf16x2_t __attribute__((ext_vector_type(2)));
__device__ __forceinline__ unsigned pk_bf16(float lo, float hi) { const f32x2 v = {lo, hi}; return __builtin_bit_cast(unsigned, __builtin_convertvector(v, bf16x2_t)); }
__device__ __forceinline__ float bflo(unsigned w) { return __uint_as_float(w << 16); }
__device__ __forceinline__ float bfhi(unsigned w) { return __uint_as_float(w & 0xffff0000u); }
__device__ __forceinline__ float sigmoidf_(float v) { return __builtin_amdgcn_rcpf(1.f + __expf(-v)); }
__device__ __forceinline__ unsigned pk_h16(float lo, float hi) { h16x2 h; h.x = (_Float16)lo; h.y = (_Float16)hi; return __builtin_bit_cast(unsigned, h); }

template <int CTRL> __device__ __forceinline__ float dppf(float old, float v) { return __int_as_float(__builtin_amdgcn_update_dpp(__float_as_int(old), __float_as_int(v), CTRL, 0xf, 0xf, false)); }

constexpr int BM = 256, BK = 64, HALF = 128, HTB = HALF * BK * 2;
__device__ __forceinline__ int lds_byte(int r, int c) { const int st = (r >> 4) * 2 + (c >> 5), rr = r & 15, cc = c & 31, ob = rr * 64 + cc * 2; return st * 1024 + (ob ^ (((ob >> 9) & 1) << 5)); }
__device__ __forceinline__ void stage_rc(int b, int& R, int& C) { const int st = b / 1024, sb = b % 1024, swz = sb ^ (((sb >> 9) & 1) << 5); R = (st >> 1) * 16 + swz / 64; C = (st & 1) * 32 + (swz % 64) / 2; }
__device__ __forceinline__ int perm32(int rho) { const int n = rho >> 4, i = rho & 15; return 8 * (i >> 2) + 4 * n + (i & 3); }

struct Unit { const char* a; const char* b; int pm; int pn; };

struct Sched {
    int phase;
    int nN, ntiles, nsub, G, c;
    const unsigned char* ws;
    __device__ __forceinline__ bool next(int ui, Unit& u) const {
        const int tile = (nsub == 2) ? (ui >> 1) : ui, g = (nsub == 2) ? (ui & 1) : 0;
        const long L = (long)tile * G + c;
        if (L >= ntiles) return false;
        int wgid = (int)L;
        { const int q = ntiles / 8, r = ntiles % 8, xcd = wgid % 8, off = wgid / 8; wgid = (xcd < r ? xcd * (q + 1) : r * (q + 1) + (xcd - r) * q) + off; }
        const int nM = 64, nig = 8 * nN, gid = wgid / nig, fm = gid * 8, gsz = (nM - fm) < 8 ? (nM - fm) : 8;
        const int pm = fm + ((wgid % nig) % gsz), j = (wgid % nig) / gsz;
        u.pm = pm;
        if (phase == 1 || phase == 2) { const int pn = (phase == 1) ? j : j + 28; u.pn = pn;
            u.a = (const char*)ws + OFF_XB + (size_t)pm * 256 * 1024 * 2; u.b = (const char*)ws + OFF_WINT + (size_t)pn * 256 * 1024 * 2; }
        else if (phase == 4) { u.pn = j + 4 * g;
            u.a = (const char*)ws + OFF_A1 + (size_t)pm * 256 * 2048 * 2 + (size_t)g * 1024 * 2; u.b = (const char*)ws + (g ? OFF_WHT : OFF_WGT) + (size_t)j * 256 * 1024 * 2; }
        else { u.pn = j;
            u.a = (const char*)g_ext + X_Y + (size_t)pm * 256 * 1024 * 2; u.b = (const char*)ws + OFF_WOT + (size_t)j * 256 * 1024 * 2; }
        return true;
    }
};

__device__ __forceinline__ void unpack8(const u32x4& w, float (&f)[8]) {
    f[0] = bflo(w.x); f[1] = bfhi(w.x); f[2] = bflo(w.y); f[3] = bfhi(w.y); f[4] = bflo(w.z); f[5] = bfhi(w.z); f[6] = bflo(w.w); f[7] = bfhi(w.w);
}
__device__ __forceinline__ u32x4 pack8(const f32x4& v0, const f32x4& v1) { u32x4 w; w.x = pk_bf16(v0[0], v0[1]); w.y = pk_bf16(v0[2], v0[3]); w.z = pk_bf16(v1[0], v1[1]); w.w = pk_bf16(v1[2], v1[3]); return w; }

template <bool HG, bool BWD>
__device__ __forceinline__ void decay_epi(const f32x4 (&acc)[2][2][4][2], u16* D, u16* D2, const float* cvec, int ld, int col0, int rbase, int cbase) {
    int tidx = threadIdx.x; asm volatile("" : "+v"(tidx));
    const int lane = tidx & 63;
    const int srcl = BWD ? (lane & 48) : ((lane & 48) | 15);
#pragma unroll
    for (int bj = 0; bj < 2; ++bj)
#pragma unroll
        for (int n = 0; n < 2; ++n) {
            const int cc = col0 + bj * 128 + cbase + 4 * n;
            const f32x4 cv = *(const f32x4*)(cvec + cc);
#pragma unroll
            for (int ai = 0; ai < 2; ++ai) {
                f32x4 sv[4], omf[4];
#pragma unroll
                for (int m = 0; m < 4; ++m)
#pragma unroll
                    for (int e = 0; e < 4; ++e) { const float a = acc[ai][bj][m][n][e];
                        if (HG) { const float f = cv[e] + (1.f - cv[e]) * sigmoidf_(a); sv[m][e] = f; omf[m][e] = 1.f - f; }
                        else { const float z = a + cv[e]; const float g = (fminf(z, 0.f) - __logf(1.f + __expf(-fabsf(z)))) * 0.0625f; sv[m][e] = g; } }
#pragma unroll
                for (int m = 0; m < 4; ++m)
#pragma unroll
                    for (int e = 0; e < 4; ++e) { float s = sv[m][e];
                        if (HG) { if (BWD) { s *= dppf<0x101>(1.f, s); s *= dppf<0x102>(1.f, s); s *= dppf<0x104>(1.f, s); s *= dppf<0x108>(1.f, s); }
                                  else { s *= dppf<0x111>(1.f, s); s *= dppf<0x112>(1.f, s); s *= dppf<0x114>(1.f, s); s *= dppf<0x118>(1.f, s); } }
                        else { if (BWD) { s += dppf<0x101>(0.f, s); s += dppf<0x102>(0.f, s); s += dppf<0x104>(0.f, s); s += dppf<0x108>(0.f, s); }
                               else { s += dppf<0x111>(0.f, s); s += dppf<0x112>(0.f, s); s += dppf<0x114>(0.f, s); s += dppf<0x118>(0.f, s); } }
                        sv[m][e] = s; }
                __builtin_amdgcn_sched_barrier(0);
#pragma unroll
                for (int e = 0; e < 4; ++e) {
                    float off = HG ? 1.f : 0.f;
#pragma unroll
                    for (int mm = 0; mm < 4; ++mm) { constexpr int dummy = 0; (void)dummy;
                        const int m = BWD ? 3 - mm : mm;
                        const float tot = __shfl(sv[m][e], srcl);
                        if (HG) { sv[m][e] *= off; off *= tot; } else { sv[m][e] += off; off += tot; } }
                }
#pragma unroll
                for (int m = 0; m < 4; ++m) { const unsigned idx = (unsigned)((rbase + ai * 128 + m * 16) * ld + cc);
                    f32x4 e0;
#pragma unroll
                    for (int e = 0; e < 4; ++e) e0[e] = HG ? sv[m][e] : __expf(sv[m][e]);
                    *(u32x2*)(D + idx) = (u32x2){pk_bf16(e0[0], e0[1]), pk_bf16(e0[2], e0[3])};
                    if (HG) { f32x4 k0;
#pragma unroll
                        for (int e = 0; e < 4; ++e) k0[e] = omf[m][e] * __builtin_amdgcn_rcpf(e0[e]);
                        *(u32x2*)(D2 + idx) = (u32x2){pk_bf16(k0[0], k0[1]), pk_bf16(k0[2], k0[3])}; }
                    __builtin_amdgcn_sched_barrier(0); }
                __builtin_amdgcn_sched_barrier(0);
            }
        }
}


constexpr int L_NORMX = 131088;
__device__ __forceinline__ void gate_norm_epi(const Params& p, const Unit& u, const f32x4 (&acc)[2][2][4][2], bool hgrn, int j, LAS unsigned char* lds) {
    int tidx = threadIdx.x; asm volatile("" : "+v"(tidx));
    const int lane = tidx & 63, wid = __builtin_amdgcn_readfirstlane(tidx >> 6), wr = wid >> 2, wc = wid & 3, fr = lane & 15, fq = lane >> 4;
    const u16* Of = hgrn ? (const u16*)(g_ext + X_OHF) : (const u16*)((const unsigned char*)p.out + OFF_OAF);
    const u16* Ob = hgrn ? (const u16*)(g_ext + X_OHB) : (const u16*)((const unsigned char*)p.out + OFF_OAB);
    const float* gain = hgrn ? p.hg_g : p.gla_g;
    u16* A1 = (u16*)(p.ws + OFF_A1) + (hgrn ? 1024 : 0);
    LAS float* X = (LAS float*)(lds + L_NORMX);
    const int rloc = wr * 64 + fr, cbase = wc * 32 + 8 * fq;
#pragma unroll
    for (int ai = 0; ai < 2; ++ai)
#pragma unroll
        for (int m = 0; m < 4; ++m) {
            float ss[2];
#pragma unroll
            for (int bj = 0; bj < 2; ++bj) { const size_t idx = (size_t)(u.pm * 256 + rloc + ai * 128 + m * 16) * 1024 + j * 256 + bj * 128 + cbase;
                const u32x4 a = *(const u32x4*)(Of + idx), b = *(const u32x4*)(Ob + idx);
                float fa[8], fb[8]; unpack8(a, fa); unpack8(b, fb);
                float s = 0.f;
#pragma unroll
                for (int e = 0; e < 8; ++e) { const float o = fa[e] + fb[e]; s += o * o; }
                s += __shfl_xor(s, 16); s += __shfl_xor(s, 32);
                ss[bj] = s; }
            asm volatile("" : "+v"(ss[0]), "+v"(ss[1]));
            if (fq == 0) { X[((rloc + ai * 128 + m * 16) * 2 + 0) * 4 + wc] = ss[0]; X[((rloc + ai * 128 + m * 16) * 2 + 1) * 4 + wc] = ss[1]; }
        }
    asm volatile("s_waitcnt lgkmcnt(0)" ::: "memory"); __builtin_amdgcn_s_barrier(); asm volatile("" ::: "memory");
#pragma unroll
    for (int bj = 0; bj < 2; ++bj) {
        const f32x4 g0 = *(const f32x4*)(gain + (hgrn ? 0 : bj * 128) + cbase), g1 = *(const f32x4*)(gain + (hgrn ? 0 : bj * 128) + cbase + 4);
#pragma unroll
        for (int ai = 0; ai < 2; ++ai)
#pragma unroll
            for (int m = 0; m < 4; ++m) { const int rl = rloc + ai * 128 + m * 16;
                const f32x4 x0 = *(const LAS f32x4*)(X + (rl * 2 + 0) * 4), x1 = *(const LAS f32x4*)(X + (rl * 2 + 1) * 4);
                const float t0 = (x0[0] + x0[1]) + (x0[2] + x0[3]), t1 = (x1[0] + x1[1]) + (x1[2] + x1[3]);
                const float rs = hgrn ? rsqrtf((bj ? t1 : t0) * (1.f / 128.f) + 1e-6f) : rsqrtf((t0 + t1) * (1.f / 256.f) + 1e-6f);
                const size_t idx = (size_t)(u.pm * 256 + rl) * 1024 + j * 256 + bj * 128 + cbase;
                const u32x4 a = *(const u32x4*)(Of + idx), b = *(const u32x4*)(Ob + idx);
                float fa[8], fb[8]; unpack8(a, fa); unpack8(b, fb);
                f32x4 r0, r1;
#pragma unroll
                for (int e = 0; e < 4; ++e) { const float ga = acc[ai][bj][m][0][e], gb = acc[ai][bj][m][1][e];
                    r0[e] = (fa[e] + fb[e]) * rs * g0[e] * (ga * sigmoidf_(ga)); r1[e] = (fa[4 + e] + fb[4 + e]) * rs * g1[e] * (gb * sigmoidf_(gb)); }
                asm volatile("" : "+v"(r0), "+v"(r1));
                *(u32x4*)(A1 + (size_t)(u.pm * 256 + rl) * 2048 + j * 256 + bj * 128 + cbase) = pack8(r0, r1); }
    }
    asm volatile("s_waitcnt lgkmcnt(0)" ::: "memory"); __builtin_amdgcn_s_barrier(); asm volatile("" ::: "memory");
}

__device__ __forceinline__ void epilogue(const Params& p, int phase, const Unit& u, const f32x4 (&acc)[2][2][4][2], int wr, int wc, int fr, int fq, LAS unsigned char* lds) {
    unsigned char* ws = p.ws;
    const int rbase = u.pm * 256 + wr * 64 + fr, cbase = wc * 32 + 8 * fq;
    if (phase == 1 || phase == 2) {
        const int pn = u.pn;
        int kind; unsigned char* dbase = ws; size_t doff; int ld = 1024, col0; float scale = 1.f;
        if (pn < 2) { kind = 0; doff = OFF_Q; ld = 512; col0 = pn * 256; scale = 0.08838834764831845f; }
        else if (pn < 4) { kind = 0; doff = OFF_K; ld = 512; col0 = (pn - 2) * 256; }
        else if (pn < 8) { kind = 0; doff = OFF_V; col0 = (pn - 4) * 256; }
        else if (pn < 10) { kind = 5; doff = OFF_EAF; ld = 512; col0 = (pn - 8) * 256; }
        else if (pn < 12) { kind = 6; doff = OFF_EAB; ld = 512; col0 = (pn - 10) * 256; }
        else if (pn < 16) { kind = 1; doff = OFF_HQ; col0 = (pn - 12) * 256; scale = 0.08838834764831845f; }
        else if (pn < 20) { kind = 3; doff = OFF_EF; col0 = (pn - 16) * 256; }
        else if (pn < 24) { kind = 4; dbase = g_ext; doff = X_EB; col0 = (pn - 20) * 256; }
        else if (pn < 28) { kind = 0; doff = OFF_HV; col0 = (pn - 24) * 256; }
        else if (pn < 32) { gate_norm_epi(p, u, acc, false, pn - 28, lds); return; }
        else if (pn < 36) { gate_norm_epi(p, u, acc, true, pn - 32, lds); return; }
        else if (pn < 40) { kind = 2; doff = OFF_MG; col0 = (pn - 36) * 256; }
        else { kind = 2; doff = OFF_MH; col0 = (pn - 40) * 256; }
        u16* D = (u16*)(dbase + doff);
        if (kind == 0) {
#pragma unroll
            for (int ai = 0; ai < 2; ++ai)
#pragma unroll
                for (int m = 0; m < 4; ++m)
#pragma unroll
                    for (int bj = 0; bj < 2; ++bj) { u16* dst = D + (size_t)(rbase + ai * 128 + m * 16) * ld + col0 + bj * 128 + cbase;
                        *(u32x4*)dst = pack8(acc[ai][bj][m][0] * scale, acc[ai][bj][m][1] * scale); }
        } else if (kind == 1) {
#pragma unroll
            for (int ai = 0; ai < 2; ++ai)
#pragma unroll
                for (int m = 0; m < 4; ++m)
#pragma unroll
                    for (int bj = 0; bj < 2; ++bj) { u16* dst = D + (size_t)(rbase + ai * 128 + m * 16) * ld + col0 + bj * 128 + cbase;
                        f32x4 a = acc[ai][bj][m][0], b = acc[ai][bj][m][1];
#pragma unroll
                        for (int e = 0; e < 4; ++e) { a[e] = a[e] * sigmoidf_(a[e]) * scale; b[e] = b[e] * sigmoidf_(b[e]) * scale; }
                        *(u32x4*)dst = pack8(a, b); }
        } else if (kind == 2) {
#pragma unroll
            for (int ai = 0; ai < 2; ++ai)
#pragma unroll
                for (int m = 0; m < 4; ++m)
#pragma unroll
                    for (int bj = 0; bj < 2; ++bj) { u16* dst = D + (size_t)(rbase + ai * 128 + m * 16) * ld + col0 + bj * 128 + cbase;
                        f32x4 a = acc[ai][bj][m][0], b = acc[ai][bj][m][1];
#pragma unroll
                        for (int e = 0; e < 4; ++e) { a[e] = sigmoidf_(a[e]); b[e] = sigmoidf_(b[e]); }
                        *(u32x4*)dst = pack8(a, b); }
        } else {
            u16* D2 = (u16*)(g_ext + ((kind == 4) ? X_KEB : X_KEF));
            const float* lbp = (const float*)(ws + OFF_LB);
            if (kind == 3) decay_epi<true, false>(acc, D, D2, lbp, ld, col0, rbase, cbase);
            else if (kind == 4) decay_epi<true, true>(acc, D, D2, lbp + 1024, ld, col0, rbase, cbase);
            else if (kind == 5) decay_epi<false, false>(acc, D, D2, p.bias_f, ld, col0, rbase, cbase);
            else decay_epi<false, true>(acc, D, D2, p.bias_b, ld, col0, rbase, cbase);
        }
    } else if (phase == 4) {
        const int g = u.pn >> 2, j = u.pn & 3;
        const u16* Gt = (const u16*)(ws + (g ? OFF_MH : OFF_MG));
        u16* Y = (u16*)(g_ext + X_Y);
#pragma unroll
        for (int ai = 0; ai < 2; ++ai)
#pragma unroll
            for (int m = 0; m < 4; ++m)
#pragma unroll
                for (int bj = 0; bj < 2; ++bj) { const size_t idx = (size_t)(rbase + ai * 128 + m * 16) * 1024 + j * 256 + bj * 128 + cbase;
                    const u32x4 gw = *(const u32x4*)(Gt + idx);
                    f32x4 a = acc[ai][bj][m][0], b = acc[ai][bj][m][1];
                    a[0] *= bflo(gw.x); a[1] *= bfhi(gw.x); a[2] *= bflo(gw.y); a[3] *= bfhi(gw.y);
                    b[0] *= bflo(gw.z); b[1] *= bfhi(gw.z); b[2] *= bflo(gw.w); b[3] *= bfhi(gw.w);
                    if (g) { const u32x4 yw = *(const u32x4*)(Y + idx);
                        a[0] += bflo(yw.x); a[1] += bfhi(yw.x); a[2] += bflo(yw.y); a[3] += bfhi(yw.y);
                        b[0] += bflo(yw.z); b[1] += bfhi(yw.z); b[2] += bflo(yw.w); b[3] += bfhi(yw.w); }
                    *(u32x4*)(Y + idx) = pack8(a, b); }
    } else {
        const float alpha = 1.189207115002721f;
#pragma unroll
        for (int ai = 0; ai < 2; ++ai)
#pragma unroll
            for (int m = 0; m < 4; ++m)
#pragma unroll
                for (int bj = 0; bj < 2; ++bj) { const size_t idx = (size_t)(rbase + ai * 128 + m * 16) * 1024 + u.pn * 256 + bj * 128 + cbase;
                    const f32x4 x0 = *(const f32x4*)(p.x + idx), x1 = *(const f32x4*)(p.x + idx + 4);
                    *(f32x4*)(p.out + idx) = acc[ai][bj][m][0] + alpha * x0; *(f32x4*)(p.out + idx + 4) = acc[ai][bj][m][1] + alpha * x1; }
    }
}

constexpr size_t OFF_XBUF = 61 * MiB + 64 * 1024;
constexpr int LN_CNT_WORD0 = XCD_BAR_WORDS + 1024;
__device__ __forceinline__ void ln_epilogue(const Params& p, const Unit& u, f32x4 (&v)[2][2][4][2], int, int, int, int, LAS unsigned char* lds, int, int) {
    int tidx = threadIdx.x; asm volatile("" : "+v"(tidx));
    const int lane = tidx & 63, wid = __builtin_amdgcn_readfirstlane(tidx >> 6), wr = wid >> 2, wc = wid & 3, fr = lane & 15, fq = lane >> 4;
    LAS f32x2* P = (LAS f32x2*)lds;
    LAS f32x2* S = (LAS f32x2*)(lds + 8192);
    unsigned long long* xbuf = (unsigned long long*)(p.ws + OFF_XBUF);
    unsigned* cnt = (unsigned*)(p.ws + OFF_BAR) + LN_CNT_WORD0 + 64 * u.pm;
    const float alpha = 1.189207115002721f;
    const int rbase = u.pm * 256 + wr * 64 + fr, cbase = u.pn * 256 + wc * 32 + 8 * fq;
#pragma unroll
    for (int ai = 0; ai < 2; ++ai)
#pragma unroll
        for (int m = 0; m < 4; ++m)
#pragma unroll
            for (int bj = 0; bj < 2; ++bj) { const size_t idx = (size_t)(rbase + ai * 128 + m * 16) * 1024 + cbase + bj * 128;
                const f32x4 x0 = *(const f32x4*)(p.x + idx), x1 = *(const f32x4*)(p.x + idx + 4);
                v[ai][bj][m][0] += alpha * x0; v[ai][bj][m][1] += alpha * x1;
                asm volatile("" : "+v"(v[ai][bj][m][0]), "+v"(v[ai][bj][m][1]));
            }
#pragma unroll
    for (int ai = 0; ai < 2; ++ai)
#pragma unroll
        for (int m = 0; m < 4; ++m) {
            float s = 0.f;
#pragma unroll
            for (int bj = 0; bj < 2; ++bj)
#pragma unroll
                for (int n = 0; n < 2; ++n) { const f32x4 x = v[ai][bj][m][n]; s += (x[0] + x[1]) + (x[2] + x[3]); }
            s += __shfl_xor(s, 16); s += __shfl_xor(s, 32);
            const float mw = s * (1.0f / 64.0f); float q = 0.f;
#pragma unroll
            for (int bj = 0; bj < 2; ++bj)
#pragma unroll
                for (int n = 0; n < 2; ++n) { const f32x4 d = v[ai][bj][m][n] - mw; q += (d[0] * d[0] + d[1] * d[1]) + (d[2] * d[2] + d[3] * d[3]); }
            q += __shfl_xor(q, 16); q += __shfl_xor(q, 32);
            if (fq == 0) P[(ai * 128 + wr * 64 + m * 16 + fr) * 4 + wc] = (f32x2){mw, q};
        }
    __syncthreads();
    const int row = wid * 32 + (lane & 31);
    if (lane < 32) {
        const f32x2 a = P[row * 4 + 0], b = P[row * 4 + 1], c = P[row * 4 + 2], d = P[row * 4 + 3];
        const float mt = (a.x + b.x + c.x + d.x) * 0.25f;
        const float da = a.x - mt, db = b.x - mt, dc = c.x - mt, dd = d.x - mt;
        const float m2 = (a.y + b.y) + (c.y + d.y) + 64.0f * ((da * da + db * db) + (dc * dc + dd * dd));
        unsigned long long* slot = xbuf + ((size_t)(u.pm * 256 + row) * 4 + u.pn);
        __hip_atomic_store(slot, ((unsigned long long)__float_as_uint(m2) << 32) | __float_as_uint(mt), __ATOMIC_RELAXED, __HIP_MEMORY_SCOPE_AGENT);
    }
    asm volatile("s_waitcnt vmcnt(0)" ::: "memory");
    if (lane == 0) __hip_atomic_fetch_add(cnt, 1u, __ATOMIC_RELAXED, __HIP_MEMORY_SCOPE_AGENT);
    if (wid == 0) {
        unsigned sp = 0;
        while ((unsigned)__builtin_amdgcn_readfirstlane(__hip_atomic_load(cnt, __ATOMIC_RELAXED, __HIP_MEMORY_SCOPE_AGENT)) < 32u) { __builtin_amdgcn_s_sleep(2); if (++sp > (1u << 20)) break; }
        __builtin_amdgcn_fence(__ATOMIC_ACQUIRE, "agent");
    }
    asm volatile("s_waitcnt vmcnt(0) lgkmcnt(0)" ::: "memory");
    __syncthreads();
    if (lane < 32) {
        const unsigned long long* slot = xbuf + (size_t)(u.pm * 256 + row) * 4; float mt[4], m2[4]; float ms = 0.f;
#pragma unroll
        for (int t = 0; t < 4; ++t) { const unsigned long long w = __hip_atomic_load(slot + t, __ATOMIC_RELAXED, __HIP_MEMORY_SCOPE_AGENT); mt[t] = __uint_as_float((unsigned)w); m2[t] = __uint_as_float((unsigned)(w >> 32)); ms += mt[t]; }
        const float mean = ms * 0.25f; float q = 0.f;
#pragma unroll
        for (int t = 0; t < 4; ++t) { const float dm = mt[t] - mean; q += m2[t] + 256.0f * dm * dm; }
        S[row] = (f32x2){mean, 1.0f / sqrtf(q * (1.0f / 1024.0f) + 1e-5f)};
    }
    __syncthreads();
#pragma unroll
    for (int bj = 0; bj < 2; ++bj) {
        const f32x4 g0 = *(const f32x4*)(p.ln_g + cbase + bj * 128), g1 = *(const f32x4*)(p.ln_g + cbase + bj * 128 + 4);
        const f32x4 b0 = *(const f32x4*)(p.ln_b + cbase + bj * 128), b1 = *(const f32x4*)(p.ln_b + cbase + bj * 128 + 4);
#pragma unroll
        for (int ai = 0; ai < 2; ++ai)
#pragma unroll
            for (int m = 0; m < 4; ++m) { const int rl = ai * 128 + wr * 64 + m * 16 + fr; const f32x2 st = S[rl];
                const size_t idx = (size_t)(u.pm * 256 + rl) * 1024 + cbase + bj * 128;
                *(f32x4*)(p.out + idx) = (v[ai][bj][m][0] - st.x) * st.y * g0 + b0;
                *(f32x4*)(p.out + idx + 4) = (v[ai][bj][m][1] - st.x) * st.y * g1 + b1; }
    }
}

__device__ __forceinline__ void gemm_phase(const Params& p, LAS unsigned char* lds, const Sched& S, int lda, int ldb, int K) {
    int tid = threadIdx.x; asm volatile("" : "+v"(tid));
    const int wid = __builtin_amdgcn_readfirstlane(tid >> 6), lane = tid & 63, wr = wid >> 2, wc = wid & 3, fr = lane & 15, fq = lane >> 4;
    const int nt = K / BK;
    unsigned voffA[2], voffB[2];
#pragma unroll
    for (int i = 0; i < 2; ++i) { int R, C; stage_rc(tid * 16 + i * 8192, R, C); const int Rb = (R & ~31) + perm32(R & 31);
        voffA[i] = (unsigned)(R * lda + C) * 2u; voffB[i] = (unsigned)(Rb * ldb + C) * 2u; }
    const size_t kstep = (size_t)(BK * 2);
    const size_t hstepA = (size_t)HALF * lda * 2, hstepB = (size_t)HALF * ldb * 2;
    const unsigned ldsw = (unsigned)wid * 1024u;
    const int aoff = lds_byte(wr * 64 + fr, fq * 8), boff = lds_byte(wc * 32 + fr, fq * 8);
#define G_SA(b, h) (((b) * 2 + (h)) * HTB)
#define G_SB(b, h) ((4 + (b) * 2 + (h)) * HTB)
#define G_STAGE(bufoff, gbase, voff) do { _Pragma("unroll") for (int _i = 0; _i < 2; ++_i) \
        __builtin_amdgcn_global_load_lds((const unsigned*)((const char*)(gbase) + (voff)[_i]), (LAS unsigned*)(lds + (bufoff) + ldsw + _i * 8192), 16, 0, 0); } while (0)
#define G_LDA(dst, b, h) do { _Pragma("unroll") for (int m = 0; m < 4; ++m) _Pragma("unroll") for (int k = 0; k < 2; ++k) dst[m][k] = *(const LAS bf16x8*)(lds + G_SA(b, h) + aoff + m * 2048 + k * 1024); } while (0)
#define G_LDB(dst, b, h) do { _Pragma("unroll") for (int n = 0; n < 2; ++n) _Pragma("unroll") for (int k = 0; k < 2; ++k) dst[n][k] = *(const LAS bf16x8*)(lds + G_SB(b, h) + boff + n * 2048 + k * 1024); } while (0)
#define G_MMA(ai, bj, At, Bt) do { __builtin_amdgcn_s_setprio(1); _Pragma("unroll") for (int m = 0; m < 4; ++m) _Pragma("unroll") for (int n = 0; n < 2; ++n) _Pragma("unroll") for (int k = 0; k < 2; ++k) \
        acc[ai][bj][m][n] = __builtin_amdgcn_mfma_f32_16x16x32_bf16(Bt[n][k], At[m][k], acc[ai][bj][m][n], 0, 0, 0); __builtin_amdgcn_s_setprio(0); } while (0)
#define G_WAIT_V(n) asm volatile("s_waitcnt vmcnt(" #n ")" ::: "memory")
#define G_WAIT_L(n) asm volatile("s_waitcnt lgkmcnt(" #n ")" ::: "memory")
#define G_BAR __builtin_amdgcn_s_barrier()
#define G_SCHED __builtin_amdgcn_sched_barrier(0)
    Unit cur, nxt; int ui = 0;
    if (!S.next(0, cur)) return;
    f32x4 acc[2][2][4][2];
#pragma unroll
    for (int a = 0; a < 2; ++a)
#pragma unroll
        for (int b = 0; b < 2; ++b)
#pragma unroll
            for (int m = 0; m < 4; ++m)
#pragma unroll
                for (int n = 0; n < 2; ++n) acc[a][b][m][n] = (f32x4){0.f, 0.f, 0.f, 0.f};
    bf16x8 At[4][2], B0[2][2], B1[2][2];
    const char* cA = cur.a; const char* cB = cur.b;
    G_STAGE(G_SB(0, 0), cB, voffB); G_STAGE(G_SB(0, 1), cB + hstepB, voffB); G_STAGE(G_SA(0, 0), cA, voffA); G_STAGE(G_SA(0, 1), cA + hstepA, voffA);
    if (wr == 1) G_BAR;
    G_WAIT_V(2); G_BAR;
    G_STAGE(G_SB(1, 0), cB + kstep, voffB); G_STAGE(G_SA(1, 0), cA + kstep, voffA); G_STAGE(G_SB(1, 1), cB + hstepB + kstep, voffB);
    G_WAIT_V(6); G_BAR;
    for (;;) {
        const bool has_next = S.next(ui + 1, nxt);
        const char* nA = has_next ? nxt.a : cA; const char* nB = has_next ? nxt.b : cB;
        for (int t = 0; t < nt; t += 2) {
            const bool last = (t == nt - 2);
            const char* a1 = cA + (size_t)(t + 1) * kstep;
            const char* a2 = last ? nA : cA + (size_t)(t + 2) * kstep; const char* b2 = last ? nB : cB + (size_t)(t + 2) * kstep;
            const char* a3 = a2 + kstep; const char* b3 = b2 + kstep;
            G_LDB(B0, 0, 0); G_LDB(B1, 0, 1); G_SCHED; G_LDA(At, 0, 0); G_STAGE(G_SA(1, 1), a1 + hstepA, voffA);
            G_WAIT_V(8); G_WAIT_L(0); G_BAR; G_MMA(0, 0, At, B0); G_MMA(0, 1, At, B1); G_BAR; G_SCHED;
            G_LDA(At, 0, 1); G_STAGE(G_SB(0, 0), b2, voffB); G_STAGE(G_SB(0, 1), b2 + hstepB, voffB); G_STAGE(G_SA(0, 0), a2, voffA);
            G_WAIT_V(8); G_WAIT_L(0); G_BAR; G_MMA(1, 0, At, B0); G_MMA(1, 1, At, B1); G_BAR; G_SCHED;
            G_LDB(B0, 1, 0); G_LDB(B1, 1, 1); G_SCHED; G_LDA(At, 1, 0); G_STAGE(G_SA(0, 1), a2 + hstepA, voffA);
            G_WAIT_V(8); G_WAIT_L(0); G_BAR; G_MMA(0, 0, At, B0); G_MMA(0, 1, At, B1); G_BAR; G_SCHED;
            G_LDA(At, 1, 1); G_STAGE(G_SB(1, 0), b3, voffB); G_STAGE(G_SB(1, 1), b3 + hstepB, voffB); G_STAGE(G_SA(1, 0), a3, voffA);
            G_WAIT_V(8); G_WAIT_L(0); G_BAR; G_MMA(1, 0, At, B0); G_MMA(1, 1, At, B1); G_BAR; G_SCHED;
        }
        if (wr == 0) G_BAR;
        if (S.phase != 5) epilogue(p, S.phase, cur, acc, wr, wc, fr, fq, lds);
        if (!has_next) break;
#pragma unroll
        for (int a = 0; a < 2; ++a)
#pragma unroll
            for (int b = 0; b < 2; ++b)
#pragma unroll
                for (int m = 0; m < 4; ++m)
#pragma unroll
                    for (int n = 0; n < 2; ++n) acc[a][b][m][n] = (f32x4){0.f, 0.f, 0.f, 0.f};
        cur = nxt; cA = nA; cB = nB; ++ui;
        if (wr == 1) G_BAR;
    }
    G_WAIT_V(0);
    G_BAR;
    if (S.phase == 5) ln_epilogue(p, cur, acc, wr, wc, fr, fq, lds, wid, lane);
}

__device__ __forceinline__ void phase0(const Params& p, LAS unsigned char* lds) {
    const int tid = threadIdx.x;
    const size_t gtid = (size_t)blockIdx.x * 512 + tid, gsz = (size_t)gridDim.x * 512;
    {
        const f32x4* x4 = (const f32x4*)p.x; u32x4* xb = (u32x4*)(p.ws + OFF_XB);
        const size_t n8 = (size_t)MTOK * DM / 8;
        for (size_t i = gtid; i < n8; i += gsz) { const f32x4 a = x4[2 * i], b = x4[2 * i + 1]; xb[i] = pack8(a, b); }
    }
    if (gtid < 2048) {
        const int d = (int)gtid & 1023; const float* L = (gtid < 1024) ? p.lbl_f : p.lbl_b;
        const float l0 = L[d], l1 = L[1024 + d];
        ((float*)(p.ws + OFF_LB))[gtid] = 1.f / (1.f + expf(l1 - l0));
    }
    LAS float* T = (LAS float*)lds;
    for (int job = blockIdx.x; job < 1408 + 384; job += gridDim.x) {
        const float* src; u16* dst; int ldw, nt64, kt, isin;
        if (job < 1408) { isin = 1; src = p.w_in; ldw = NIN; dst = (u16*)(p.ws + OFF_WINT); nt64 = job >> 3; kt = job & 7; }
        else { const int jj = job - 1408, mat = jj >> 7, r = jj & 127; isin = 0; ldw = 1024; nt64 = r >> 3; kt = r & 7;
            src = mat == 0 ? p.w_gla : (mat == 1 ? p.w_hgrn : p.w_out); dst = (u16*)(p.ws + (mat == 0 ? OFF_WGT : (mat == 1 ? OFF_WHT : OFF_WOT))); }
        const int c = tid & 63, kr = tid >> 6;
        const int m = nt64 * 64 + c;
        int orig = m; int eff = 0;
        if (isin) {
            if (m < 2048) orig = m;
            else if (m < 3072) { eff = 1; orig = m - 2048; }
            else if (m < 7168) orig = m + 32;
            else if (m < 8192) orig = 2048 + (m - 7168);
            else orig = 7200 + (m - 8192);
        }
        if (eff) {
            const int bw = orig >> 9, cc = orig & 511;
            const float* U = bw ? p.up_b : p.up_f;
            float uv[16];
#pragma unroll
            for (int r = 0; r < 16; ++r) uv[r] = U[r * 512 + cc];
            for (int i = 0; i < 16; ++i) { const int k = kr + 8 * i;
                const float* wr_ = src + (size_t)(kt * 128 + k) * ldw + 3072 + bw * 16;
                float s = 0.f;
#pragma unroll
                for (int r = 0; r < 16; ++r) s += wr_[r] * uv[r];
                T[k * 65 + c] = s; }
        } else {
#pragma unroll 4
            for (int i = 0; i < 16; ++i) { const int k = kr + 8 * i;
                T[k * 65 + c] = src[(size_t)(kt * 128 + k) * ldw + orig]; }
        }
        __syncthreads();
        const int rho = tid >> 3, kseg = tid & 7;
        float v[16];
#pragma unroll
        for (int kk = 0; kk < 16; ++kk) v[kk] = T[(kseg * 16 + kk) * 65 + rho];
        u32x4 w0, w1;
        w0.x = pk_bf16(v[0], v[1]); w0.y = pk_bf16(v[2], v[3]); w0.z = pk_bf16(v[4], v[5]); w0.w = pk_bf16(v[6], v[7]);
        w1.x = pk_bf16(v[8], v[9]); w1.y = pk_bf16(v[10], v[11]); w1.z = pk_bf16(v[12], v[13]); w1.w = pk_bf16(v[14], v[15]);
        u16* d = dst + (size_t)(nt64 * 64 + rho) * 1024 + kt * 128 + kseg * 16;
        *(u32x4*)d = w0; *(u32x4*)(d + 8) = w1;
        __syncthreads();
    }
}

constexpr int S_QE = 0, S_KE = 19456, S_V = 38912, S_PP = 48128, S_ST0 = 57344, S_ST1 = 76800, S_DEC = 96256;
constexpr int RS = 304, RV = 144;
typedef short s16x4 __attribute__((ext_vector_type(4)));
#define MFMA16(a, b, c) __builtin_amdgcn_mfma_f32_16x16x32_bf16(a, b, c, 0, 0, 0)

__device__ __forceinline__ bf16x8 tr8(LAS unsigned char* p0, int stride4) {
    const s16x4 a = __builtin_amdgcn_ds_read_tr16_b64_v4i16((LAS s16x4*)p0);
    const s16x4 b = __builtin_amdgcn_ds_read_tr16_b64_v4i16((LAS s16x4*)(p0 + stride4));
    return __builtin_shufflevector(a, b, 0, 1, 2, 3, 4, 5, 6, 7);
}

__device__ __forceinline__ void scan_phase(const Params& p, LAS unsigned char* lds) {
    const int tid = threadIdx.x, w = __builtin_amdgcn_readfirstlane(tid >> 6), lane = tid & 63, fr = lane & 15, fq = lane >> 4;
    const int ti = tid >> 3, ch = tid & 7;
    for (int u = blockIdx.x; u < 256; u += gridDim.x) {
        const int xcd = u & 7, slot = u >> 3;
        const bool isg = slot < 16;
        int bb, hh, dir, e0, ldq;
        const u16 *Qp, *Ep, *Kp, *Vp; u16* Op;
        if (isg) { const int grp = xcd + 8 * (slot >> 2), sl = slot & 3; bb = grp >> 3; hh = (grp >> 1) & 3; dir = grp & 1; e0 = hh * 256 + sl * 64; ldq = 512;
            Qp = (const u16*)(p.ws + OFF_Q); Kp = (const u16*)(p.ws + OFF_K); Ep = (const u16*)(p.ws + (dir ? OFF_EAB : OFF_EAF)); Vp = (const u16*)(p.ws + OFF_V);
            Op = (u16*)((unsigned char*)p.out + (dir ? OFF_OAB : OFF_OAF)); }
        else { const int s = slot - 16, grp = xcd + 8 * (s >> 1), sl = s & 1; bb = grp >> 4; hh = (grp >> 1) & 7; dir = grp & 1; e0 = hh * 128 + sl * 64; ldq = 1024;
            Qp = (const u16*)(p.ws + OFF_HQ); Vp = (const u16*)(p.ws + OFF_HV);
            Ep = dir ? (const u16*)(g_ext + X_EB) : (const u16*)(p.ws + OFF_EF); Kp = (const u16*)(g_ext + (dir ? X_KEB : X_KEF));
            Op = (u16*)(g_ext + (dir ? X_OHB : X_OHF)); }
        const int qc = hh * 128 + ch * 16;
        const int tb = bb * SEQ, sgn = dir ? -1 : 1;
        for (int i = tid; i < 19456 / 4; i += 512) *(LAS unsigned*)(lds + S_ST0 + i * 4) = 0u;
        f32x4 sacc[4];
#pragma unroll
        for (int ne = 0; ne < 4; ++ne) sacc[ne] = (f32x4){0.f, 0.f, 0.f, 0.f};
        u32x4 rq[2], re[2], rk[2], rv;
        {
            const size_t t = (size_t)(tb + (dir ? SEQ - 1 : 0) + sgn * ti);
            rq[0] = *(const u32x4*)(Qp + t * ldq + qc); rq[1] = *(const u32x4*)(Qp + t * ldq + qc + 8);
            re[0] = *(const u32x4*)(Ep + t * ldq + qc); re[1] = *(const u32x4*)(Ep + t * ldq + qc + 8);
            rk[0] = *(const u32x4*)(Kp + t * ldq + qc); rk[1] = *(const u32x4*)(Kp + t * ldq + qc + 8);
            rv = *(const u32x4*)(Vp + t * 1024 + e0 + ch * 8);
        }
        __syncthreads();
        for (int c = 0; c < 64; ++c) {
            const int base = tb + (dir ? SEQ - 1 - 64 * c : 64 * c);
#pragma unroll
            for (int hf = 0; hf < 2; ++hf) {
                float q[8], e[8];
                unpack8(rq[hf], q); unpack8(re[hf], e);
                f32x4 a0, a1;
#pragma unroll
                for (int x = 0; x < 4; ++x) { a0[x] = q[x] * e[x]; a1[x] = q[4 + x] * e[4 + x]; }
                *(LAS u32x4*)(lds + S_QE + ti * RS + ch * 32 + hf * 16) = pack8(a0, a1);
                if (isg) { float k[8]; unpack8(rk[hf], k);
#pragma unroll
                    for (int x = 0; x < 4; ++x) { a0[x] = k[x] * __builtin_amdgcn_rcpf(e[x]); a1[x] = k[4 + x] * __builtin_amdgcn_rcpf(e[4 + x]); }
                    *(LAS u32x4*)(lds + S_KE + ti * RS + ch * 32 + hf * 16) = pack8(a0, a1); }
                else *(LAS u32x4*)(lds + S_KE + ti * RS + ch * 32 + hf * 16) = rk[hf];
                if (ti == 63) { *(LAS f32x4*)(lds + S_DEC + (ch * 16 + hf * 8) * 4) = (f32x4){e[0], e[1], e[2], e[3]}; *(LAS f32x4*)(lds + S_DEC + (ch * 16 + hf * 8 + 4) * 4) = (f32x4){e[4], e[5], e[6], e[7]}; }
            }
            *(LAS u32x4*)(lds + S_V + ti * RV + ch * 16) = rv;
            if (c < 63) {
                const size_t t = (size_t)(tb + (dir ? SEQ - 1 - 64 * (c + 1) : 64 * (c + 1)) + sgn * ti);
                rq[0] = *(const u32x4*)(Qp + t * ldq + qc); rq[1] = *(const u32x4*)(Qp + t * ldq + qc + 8);
                re[0] = *(const u32x4*)(Ep + t * ldq + qc); re[1] = *(const u32x4*)(Ep + t * ldq + qc + 8);
                rk[0] = *(const u32x4*)(Kp + t * ldq + qc); rk[1] = *(const u32x4*)(Kp + t * ldq + qc + 8);
                rv = *(const u32x4*)(Vp + t * 1024 + e0 + ch * 8);
            }
            __syncthreads();
            bf16x8 bqs[4], vfr[2][2];
            {
                const int mi = w >> 1, njb = (w & 1) * 2;
                f32x4 sc[2]; sc[0] = (f32x4){0.f, 0.f, 0.f, 0.f}; sc[1] = sc[0];
#pragma unroll
                for (int kk = 0; kk < 4; ++kk) { const bf16x8 bq = *(const LAS bf16x8*)(lds + S_QE + (16 * mi + fr) * RS + (32 * kk + 8 * fq) * 2); bqs[kk] = bq;
#pragma unroll
                    for (int n2 = 0; n2 < 2; ++n2) if (njb + n2 <= mi) {
                        const bf16x8 ak = *(const LAS bf16x8*)(lds + S_KE + (16 * (njb + n2) + fr) * RS + (32 * kk + 8 * fq) * 2); sc[n2] = MFMA16(ak, bq, sc[n2]); } }
                const int i = 16 * mi + fr;
#pragma unroll
                for (int n2 = 0; n2 < 2; ++n2) { const int j0 = 16 * (njb + n2) + 4 * fq;
                    const float m0 = (i >= j0) ? sc[n2][0] : 0.f, m1 = (i >= j0 + 1) ? sc[n2][1] : 0.f, m2 = (i >= j0 + 2) ? sc[n2][2] : 0.f, m3 = (i >= j0 + 3) ? sc[n2][3] : 0.f;
                    *(LAS u32x2*)(lds + S_PP + i * RV + j0 * 2) = (u32x2){pk_bf16(m0, m1), pk_bf16(m2, m3)}; }
            }
            const int stold = (c & 1) ? S_ST1 : S_ST0, stnew = (c & 1) ? S_ST0 : S_ST1;
            {
#pragma unroll
                for (int kk = 0; kk < 2; ++kk) {
                    const int jr = 32 * kk + 8 * fq + (fr >> 2);
                    const bf16x8 a = tr8(lds + S_KE + jr * RS + (16 * w + 4 * (fr & 3)) * 2, 4 * RS);
#pragma unroll
                    for (int ne = 0; ne < 4; ++ne) { const bf16x8 bv = tr8(lds + S_V + jr * RV + (16 * ne + 4 * (fr & 3)) * 2, 4 * RV); sacc[ne] = MFMA16(a, bv, sacc[ne]);
                        if ((w & 1) == (ne >> 1)) vfr[kk][ne & 1] = bv; } }
                const f32x4 dec = *(const LAS f32x4*)(lds + S_DEC + (16 * w + 4 * fq) * 4);
#pragma unroll
                for (int ne = 0; ne < 4; ++ne) { sacc[ne] = sacc[ne] * dec;
                    *(LAS u32x2*)(lds + stnew + (16 * ne + fr) * RS + (16 * w + 4 * fq) * 2) = (u32x2){pk_bf16(sacc[ne][0], sacc[ne][1]), pk_bf16(sacc[ne][2], sacc[ne][3])}; }
            }
            __syncthreads();
            {
                const int mi = w >> 1, neb = (w & 1) * 2;
                f32x4 oa[2]; oa[0] = (f32x4){0.f, 0.f, 0.f, 0.f}; oa[1] = oa[0];
#pragma unroll
                for (int kk = 0; kk < 4; ++kk) { const bf16x8 b = bqs[kk];
#pragma unroll
                    for (int n2 = 0; n2 < 2; ++n2) { const bf16x8 a = *(const LAS bf16x8*)(lds + stold + (16 * (neb + n2) + fr) * RS + (32 * kk + 8 * fq) * 2); oa[n2] = MFMA16(a, b, oa[n2]); } }
#pragma unroll
                for (int kk = 0; kk < 2; ++kk) { const bf16x8 b = *(const LAS bf16x8*)(lds + S_PP + (16 * mi + fr) * RV + (32 * kk + 8 * fq) * 2);
#pragma unroll
                    for (int n2 = 0; n2 < 2; ++n2) { oa[n2] = MFMA16(vfr[kk][n2], b, oa[n2]); } }
                u16* optr = Op + (size_t)(base + sgn * (16 * mi + fr)) * 1024 + e0 + 16 * neb + 4 * fq;
                *(u32x2*)optr = (u32x2){pk_bf16(oa[0][0], oa[0][1]), pk_bf16(oa[0][2], oa[0][3])};
                *(u32x2*)(optr + 16) = (u32x2){pk_bf16(oa[1][0], oa[1][1]), pk_bf16(oa[1][2], oa[1][3])};
            }
            __syncthreads();
        }
    }
}

#define XB_TMO      128
#define XB_XCNT(j)  (256  + 64 * (j))
#define XB_XSUB(j)  (1280 + 64 * (j))
#define XB_XGEN(j)  (2304 + 64 * (j))
#define XB_TOP      3328
#define XB_TOPGEN   3392
#define XB_SPIN_CAP (1u << 18)
__device__ __forceinline__ unsigned xb_ld(unsigned* p)              { return __hip_atomic_load(p, __ATOMIC_RELAXED, __HIP_MEMORY_SCOPE_AGENT); }
__device__ __forceinline__ unsigned xb_add(unsigned* p, unsigned v) { return __hip_atomic_fetch_add(p, v, __ATOMIC_RELAXED, __HIP_MEMORY_SCOPE_AGENT); }
__device__ __forceinline__ unsigned xb_xcc_id() { return (unsigned)__builtin_amdgcn_s_getreg((3 << 11) | 20) & 0xFu; }
#define XB_SPIN(cond, bar) do { unsigned _sp = 0; while (cond) { __builtin_amdgcn_s_sleep(1); \
    if ((++_sp & 255u) == 0u) { if (xb_ld(&(bar)[XB_TMO])) break; if (_sp > XB_SPIN_CAP) { atomicAdd(&(bar)[XB_TMO], 1u); break; } } } } while (0)
struct XcdBarrier { unsigned* bar; unsigned x; volatile LAS unsigned* st; };
__device__ __forceinline__ XcdBarrier xcd_barrier_post(unsigned* bar, volatile LAS unsigned* st) {
    XcdBarrier b; b.bar = bar; b.x = xb_xcc_id(); b.st = st;
    if (threadIdx.x == 0) (void)xb_add(&bar[XB_XCNT(b.x)], 1u);
    return b;
}
__device__ __forceinline__ void xcd_barrier_complete(unsigned* bar, unsigned x, unsigned& nloc, unsigned& nx) {
    const unsigned G = gridDim.x * gridDim.y * gridDim.z;
    unsigned sum, cnt, mine, sp = 0u;
    for (;;) {
        sum = 0u; cnt = 0u; mine = 0u;
#pragma unroll
        for (unsigned j = 0; j < 16; ++j) { const unsigned c = xb_ld(&bar[XB_XCNT(j)]); sum += c; cnt += (c > 0u) ? 1u : 0u; mine = (j == x) ? c : mine; }
        if (sum == G) break;
        __builtin_amdgcn_s_sleep(1);
        if ((++sp & 255u) == 0u) { if (xb_ld(&bar[XB_TMO])) break; if (sp > XB_SPIN_CAP) { atomicAdd(&bar[XB_TMO], 1u); break; } }
    }
    nloc = mine > 0u ? mine : 1u; nx = cnt > 0u ? cnt : 1u;
}
__device__ __forceinline__ void xcd_barrier(const XcdBarrier& b) {
    asm volatile("s_waitcnt vmcnt(0)" ::: "memory");
    __syncthreads();
    if (threadIdx.x == 0) {
        unsigned* bar = b.bar;
        __builtin_amdgcn_s_waitcnt(0);
        unsigned nloc = b.st[0], nx = b.st[1];
        if (nloc == 0u) { xcd_barrier_complete(bar, b.x, nloc, nx); b.st[0] = nloc; b.st[1] = nx; }
        const unsigned old = xb_add(&bar[XB_XSUB(b.x)], 1u);
        const unsigned gen = old / nloc;
        if (old + 1u == (gen + 1u) * nloc) {
            __builtin_amdgcn_fence(__ATOMIC_RELEASE, "agent");
            asm volatile("s_waitcnt vmcnt(0)" ::: "memory");
            const unsigned og = xb_add(&bar[XB_TOP], 1u);
            const unsigned tg = og / nx;
            if (og + 1u == (tg + 1u) * nx) xb_add(&bar[XB_TOPGEN], 1u);
            else XB_SPIN(xb_ld(&bar[XB_TOPGEN]) == tg, bar);
            __builtin_amdgcn_fence(__ATOMIC_ACQUIRE, "agent");
            xb_add(&bar[XB_XGEN(b.x)], 1u);
            asm volatile("s_waitcnt vmcnt(0)" ::: "memory");
        } else {
            XB_SPIN(xb_ld(&bar[XB_XGEN(b.x)]) == gen, bar);
            __builtin_amdgcn_fence(__ATOMIC_ACQUIRE, "agent");
            asm volatile("s_waitcnt vmcnt(0)" ::: "memory");
        }
    }
    __syncthreads();
}

__global__ void __launch_bounds__(512) mega(Params p) {
    extern __shared__ __attribute__((aligned(16))) unsigned char lds_raw[];
    LAS unsigned char* lds = (LAS unsigned char*)lds_raw;
    cg::grid_group grid = cg::this_grid();
    volatile LAS unsigned* xst = (volatile LAS unsigned*)(lds + 131072);
    if (threadIdx.x == 0) { xst[0] = 0u; xst[1] = 0u; xst[2] = 0u; xst[3] = 0u; }
    __syncthreads();
    const XcdBarrier xb = xcd_barrier_post((unsigned*)(p.ws + OFF_BAR), xst);
    Sched S; S.G = gridDim.x; S.c = blockIdx.x; S.ws = p.ws;
    if (p.ws == nullptr) grid.sync();
    phase0(p, lds);
    xcd_barrier(xb);
    S.phase = 1; S.nN = 28; S.ntiles = 64 * 28; S.nsub = 1;
    gemm_phase(p, lds, S, 1024, 1024, 1024);
    xcd_barrier(xb);
    scan_phase(p, lds);
    xcd_barrier(xb);
    S.phase = 2; S.nN = 16; S.ntiles = 64 * 16; S.nsub = 1;
    gemm_phase(p, lds, S, 1024, 1024, 1024);
    xcd_barrier(xb);
    S.phase = 4; S.nN = 4; S.ntiles = 256; S.nsub = 2;
    gemm_phase(p, lds, S, 2048, 1024, 1024);
    xcd_barrier(xb);
    S.phase = 5; S.nN = 4; S.ntiles = 256; S.nsub = 1;
    gemm_phase(p, lds, S, 1024, 1024, 1024);
}

extern "C" void kernel_launch(void* const* d_in, const int* in_sizes, int n_in,
                              void* d_out, int out_size, void* d_ws, size_t ws_size,
                              hipStream_t stream) {
    constexpr size_t kDynLds = 131088 + 8192;
    static int grid_blocks = 0;
    if (!grid_blocks) {
        int dev = 0, cus = 0, per_cu = 0;
        (void)hipGetDevice(&dev);
        (void)hipDeviceGetAttribute(&cus, hipDeviceAttributeMultiprocessorCount, dev);
        (void)hipFuncSetAttribute((const void*)mega, hipFuncAttributeMaxDynamicSharedMemorySize, (int)kDynLds);
        (void)hipOccupancyMaxActiveBlocksPerMultiprocessor(&per_cu, mega, 512, kDynLds);
        if (per_cu < 1) per_cu = 1;
        if (per_cu > 1) per_cu = 1;
        grid_blocks = cus * per_cu;
    }
    Params p{};
    p.x = (const float*)d_in[0]; p.w_in = (const float*)d_in[1]; p.up_f = (const float*)d_in[2]; p.bias_f = (const float*)d_in[3];
    p.up_b = (const float*)d_in[4]; p.bias_b = (const float*)d_in[5]; p.gla_g = (const float*)d_in[6]; p.lbl_f = (const float*)d_in[7];
    p.lbl_b = (const float*)d_in[8]; p.hg_g = (const float*)d_in[9]; p.w_gla = (const float*)d_in[10]; p.w_hgrn = (const float*)d_in[11];
    p.w_out = (const float*)d_in[12]; p.ln_g = (const float*)d_in[13]; p.ln_b = (const float*)d_in[14];
    p.out = (float*)d_out; p.ws = (unsigned char*)d_ws;
    (void)hipMemsetAsync((unsigned char*)d_ws + OFF_BAR, 0, (XCD_BAR_WORDS + 1024 + 64 * 64) * sizeof(unsigned), stream);
    void* args[] = {&p};
    hipError_t e = hipLaunchCooperativeKernel((void*)mega, dim3(grid_blocks), dim3(512), args, kDynLds, stream);
    if (e != hipSuccess) fprintf(stderr, "cooperative launch failed: %s (grid %d)\n", hipGetErrorString(e), grid_blocks);
}
```

```cpp
#include <hip/hip_runtime.h>
#include <hip/hip_cooperative_groups.h>
#include <cstdio>
#include <cstdint>
namespace cg = cooperative_groups;

#define LAS __attribute__((address_space(3)))
typedef unsigned short u16;
typedef short bf16x8 __attribute__((ext_vector_type(8)));
typedef float f32x4 __attribute__((ext_vector_type(4)));
typedef float f32x2 __attribute__((ext_vector_type(2)));
typedef unsigned u32x4 __attribute__((ext_vector_type(4)));
typedef unsigned u32x2 __attribute__((ext_vector_type(2)));
typedef _Float16 h16x2 __attribute__((ext_vector_type(2)));

constexpr int SEQ = 4096, MTOK = 16384, DM = 1024, NIN = 10272;
constexpr size_t MiB = 1024ull * 1024ull;
constexpr size_t OFF_BAR = 61 * MiB;
#define XCD_BAR_WORDS 3456
constexpr size_t OFF_XB = 0, OFF_WINT = 32 * MiB, OFF_WGT = 54 * MiB, OFF_WHT = 56 * MiB, OFF_WOT = 58 * MiB, OFF_LB = 60 * MiB;
constexpr size_t OFF_Q = 64 * MiB, OFF_K = 80 * MiB, OFF_V = 96 * MiB, OFF_EAF = 128 * MiB, OFF_EAB = 144 * MiB, OFF_HQ = 160 * MiB, OFF_HV = 192 * MiB, OFF_EF = 224 * MiB;
constexpr size_t OFF_GATEA = 64 * MiB, OFF_HGATE = 96 * MiB, OFF_MG = 128 * MiB, OFF_MH = 160 * MiB, OFF_A1 = 192 * MiB;
constexpr size_t X_KEF = 0, X_EB = 32 * MiB, X_KEB = 64 * MiB, X_OHF = 96 * MiB, X_OHB = 128 * MiB, X_Y = 0;
__device__ __attribute__((aligned(256))) unsigned char g_ext[160 * MiB];
constexpr size_t OFF_OAF = 0, OFF_OAB = 32 * MiB;

struct Params {
    const float *x, *w_in, *up_f, *bias_f, *up_b, *bias_b, *gla_g, *lbl_f, *lbl_b, *hg_g, *w_gla, *w_hgrn, *w_out, *ln_g, *ln_b;
    float* out;
    unsigned char* ws;
};

typedef __bf16 bf16x2_t __attribute__((ext_vector_type(2)));
__device__ __forceinline__ unsigned pk_bf16(float lo, float hi) { const f32x2 v = {lo, hi}; return __builtin_bit_cast(unsigned, __builtin_convertvector(v, bf16x2_t)); }
__device__ __forceinline__ float bflo(unsigned w) { return __uint_as_float(w << 16); }
__device__ __forceinline__ float bfhi(unsigned w) { return __uint_as_float(w & 0xffff0000u); }
__device__ __forceinline__ float sigmoidf_(float v) { return __builtin_amdgcn_rcpf(1.f + __expf(-v)); }
__device__ __forceinline__ unsigned pk_h16(float lo, float hi) { h16x2 h; h.x = (_Float16)lo; h.y = (_Float16)hi; return __builtin_bit_cast(unsigned, h); }

template <int CTRL> __device__ __forceinline__ float dppf(float old, float v) { return __int_as_float(__builtin_amdgcn_update_dpp(__float_as_int(old), __float_as_int(v), CTRL, 0xf, 0xf, false)); }

constexpr int BM = 256, BK = 64, HALF = 128, HTB = HALF * BK * 2;
__device__ __forceinline__ int lds_byte(int r, int c) { const int st = (r >> 4) * 2 + (c >> 5), rr = r & 15, cc = c & 31, ob = rr * 64 + cc * 2; return st * 1024 + (ob ^ (((ob >> 9) & 1) << 5)); }
__device__ __forceinline__ void stage_rc(int b, int& R, int& C) { const int st = b / 1024, sb = b % 1024, swz = sb ^ (((sb >> 9) & 1) << 5); R = (st >> 1) * 16 + swz / 64; C = (st & 1) * 32 + (swz % 64) / 2; }
__device__ __forceinline__ int perm32(int rho) { const int n = rho >> 4, i = rho & 15; return 8 * (i >> 2) + 4 * n + (i & 3); }

struct Unit { const char* a; const char* b; int pm; int pn; };

struct Sched {
    int phase;
    int nN, ntiles, nsub, G, c;
    const unsigned char* ws;
    __device__ __forceinline__ bool next(int ui, Unit& u) const {
        const int tile = (nsub == 2) ? (ui >> 1) : ui, g = (nsub == 2) ? (ui & 1) : 0;
        const long L = (long)tile * G + c;
        if (L >= ntiles) return false;
        int wgid = (int)L;
        { const int q = ntiles / 8, r = ntiles % 8, xcd = wgid % 8, off = wgid / 8; wgid = (xcd < r ? xcd * (q + 1) : r * (q + 1) + (xcd - r) * q) + off; }
        const int nM = 64, nig = 8 * nN, gid = wgid / nig, fm = gid * 8, gsz = (nM - fm) < 8 ? (nM - fm) : 8;
        const int pm = fm + ((wgid % nig) % gsz), j = (wgid % nig) / gsz;
        u.pm = pm;
        if (phase == 1 || phase == 2) { const int pn = (phase == 1) ? j : j + 28; u.pn = pn;
            u.a = (const char*)ws + OFF_XB + (size_t)pm * 256 * 1024 * 2; u.b = (const char*)ws + OFF_WINT + (size_t)pn * 256 * 1024 * 2; }
        else if (phase == 4) { u.pn = j + 4 * g;
            u.a = (const char*)ws + OFF_A1 + (size_t)pm * 256 * 2048 * 2 + (size_t)g * 1024 * 2; u.b = (const char*)ws + (g ? OFF_WHT : OFF_WGT) + (size_t)j * 256 * 1024 * 2; }
        else { u.pn = j;
            u.a = (const char*)g_ext + X_Y + (size_t)pm * 256 * 1024 * 2; u.b = (const char*)ws + OFF_WOT + (size_t)j * 256 * 1024 * 2; }
        return true;
    }
};

__device__ __forceinline__ void unpack8(const u32x4& w, float (&f)[8]) {
    f[0] = bflo(w.x); f[1] = bfhi(w.x); f[2] = bflo(w.y); f[3] = bfhi(w.y); f[4] = bflo(w.z); f[5] = bfhi(w.z); f[6] = bflo(w.w); f[7] = bfhi(w.w);
}
__device__ __forceinline__ u32x4 pack8(const f32x4& v0, const f32x4& v1) { u32x4 w; w.x = pk_bf16(v0[0], v0[1]); w.y = pk_bf16(v0[2], v0[3]); w.z = pk_bf16(v1[0], v1[1]); w.w = pk_bf16(v1[2], v1[3]); return w; }

template <bool HG, bool BWD>
__device__ __forceinline__ void decay_epi(const f32x4 (&acc)[2][2][4][2], u16* D, u16* D2, const float* cvec, int ld, int col0, int rbase, int cbase) {
    int tidx = threadIdx.x; asm volatile("" : "+v"(tidx));
    const int lane = tidx & 63;
    const int srcl = BWD ? (lane & 48) : ((lane & 48) | 15);
#pragma unroll
    for (int bj = 0; bj < 2; ++bj)
#pragma unroll
        for (int n = 0; n < 2; ++n) {
            const int cc = col0 + bj * 128 + cbase + 4 * n;
            const f32x4 cv = *(const f32x4*)(cvec + cc);
#pragma unroll
            for (int ai = 0; ai < 2; ++ai) {
                f32x4 sv[4], omf[4];
#pragma unroll
                for (int m = 0; m < 4; ++m)
#pragma unroll
                    for (int e = 0; e < 4; ++e) { const float a = acc[ai][bj][m][n][e];
                        if (HG) { const float f = cv[e] + (1.f - cv[e]) * sigmoidf_(a); sv[m][e] = f; omf[m][e] = 1.f - f; }
                        else { const float z = a + cv[e]; const float g = (fminf(z, 0.f) - __logf(1.f + __expf(-fabsf(z)))) * 0.0625f; sv[m][e] = g; } }
#pragma unroll
                for (int m = 0; m < 4; ++m)
#pragma unroll
                    for (int e = 0; e < 4; ++e) { float s = sv[m][e];
                        if (HG) { if (BWD) { s *= dppf<0x101>(1.f, s); s *= dppf<0x102>(1.f, s); s *= dppf<0x104>(1.f, s); s *= dppf<0x108>(1.f, s); }
                                  else { s *= dppf<0x111>(1.f, s); s *= dppf<0x112>(1.f, s); s *= dppf<0x114>(1.f, s); s *= dppf<0x118>(1.f, s); } }
                        else { if (BWD) { s += dppf<0x101>(0.f, s); s += dppf<0x102>(0.f, s); s += dppf<0x104>(0.f, s); s += dppf<0x108>(0.f, s); }
                               else { s += dppf<0x111>(0.f, s); s += dppf<0x112>(0.f, s); s += dppf<0x114>(0.f, s); s += dppf<0x118>(0.f, s); } }
                        sv[m][e] = s; }
                __builtin_amdgcn_sched_barrier(0);
#pragma unroll
                for (int e = 0; e < 4; ++e) {
                    float off = HG ? 1.f : 0.f;
#pragma unroll
                    for (int mm = 0; mm < 4; ++mm) { constexpr int dummy = 0; (void)dummy;
                        const int m = BWD ? 3 - mm : mm;
                        const float tot = __shfl(sv[m][e], srcl);
                        if (HG) { sv[m][e] *= off; off *= tot; } else { sv[m][e] += off; off += tot; } }
                }
#pragma unroll
                for (int m = 0; m < 4; ++m) { const unsigned idx = (unsigned)((rbase + ai * 128 + m * 16) * ld + cc);
                    f32x4 e0;
#pragma unroll
                    for (int e = 0; e < 4; ++e) e0[e] = HG ? sv[m][e] : __expf(sv[m][e]);
                    *(u32x2*)(D + idx) = (u32x2){pk_bf16(e0[0], e0[1]), pk_bf16(e0[2], e0[3])};
                    if (HG) { f32x4 k0;
#pragma unroll
                        for (int e = 0; e < 4; ++e) k0[e] = omf[m][e] * __builtin_amdgcn_rcpf(e0[e]);
                        *(u32x2*)(D2 + idx) = (u32x2){pk_bf16(k0[0], k0[1]), pk_bf16(k0[2], k0[3])}; }
                    __builtin_amdgcn_sched_barrier(0); }
                __builtin_amdgcn_sched_barrier(0);
            }
        }
}


constexpr int L_NORMX = 131088;
__device__ __forceinline__ void gate_norm_epi(const Params& p, const Unit& u, const f32x4 (&acc)[2][2][4][2], bool hgrn, int j, LAS unsigned char* lds) {
    int tidx = threadIdx.x; asm volatile("" : "+v"(tidx));
    const int lane = tidx & 63, wid = __builtin_amdgcn_readfirstlane(tidx >> 6), wr = wid >> 2, wc = wid & 3, fr = lane & 15, fq = lane >> 4;
    const u16* Of = hgrn ? (const u16*)(g_ext + X_OHF) : (const u16*)((const unsigned char*)p.out + OFF_OAF);
    const u16* Ob = hgrn ? (const u16*)(g_ext + X_OHB) : (const u16*)((const unsigned char*)p.out + OFF_OAB);
    const float* gain = hgrn ? p.hg_g : p.gla_g;
    u16* A1 = (u16*)(p.ws + OFF_A1) + (hgrn ? 1024 : 0);
    LAS float* X = (LAS float*)(lds + L_NORMX);
    const int rloc = wr * 64 + fr, cbase = wc * 32 + 8 * fq;
#pragma unroll
    for (int ai = 0; ai < 2; ++ai)
#pragma unroll
        for (int m = 0; m < 4; ++m) {
            float ss[2];
#pragma unroll
            for (int bj = 0; bj < 2; ++bj) { const size_t idx = (size_t)(u.pm * 256 + rloc + ai * 128 + m * 16) * 1024 + j * 256 + bj * 128 + cbase;
                const u32x4 a = *(const u32x4*)(Of + idx), b = *(const u32x4*)(Ob + idx);
                float fa[8], fb[8]; unpack8(a, fa); unpack8(b, fb);
                float s = 0.f;
#pragma unroll
                for (int e = 0; e < 8; ++e) { const float o = fa[e] + fb[e]; s += o * o; }
                s += __shfl_xor(s, 16); s += __shfl_xor(s, 32);
                ss[bj] = s; }
            asm volatile("" : "+v"(ss[0]), "+v"(ss[1]));
            if (fq == 0) { X[((rloc + ai * 128 + m * 16) * 2 + 0) * 4 + wc] = ss[0]; X[((rloc + ai * 128 + m * 16) * 2 + 1) * 4 + wc] = ss[1]; }
        }
    asm volatile("s_waitcnt lgkmcnt(0)" ::: "memory"); __builtin_amdgcn_s_barrier(); asm volatile("" ::: "memory");
#pragma unroll
    for (int bj = 0; bj < 2; ++bj) {
        const f32x4 g0 = *(const f32x4*)(gain + (hgrn ? 0 : bj * 128) + cbase), g1 = *(const f32x4*)(gain + (hgrn ? 0 : bj * 128) + cbase + 4);
#pragma unroll
        for (int ai = 0; ai < 2; ++ai)
#pragma unroll
            for (int m = 0; m < 4; ++m) { const int rl = rloc + ai * 128 + m * 16;
                const f32x4 x0 = *(const LAS f32x4*)(X + (rl * 2 + 0) * 4), x1 = *(const LAS f32x4*)(X + (rl * 2 + 1) * 4);
                const float t0 = (x0[0] + x0[1]) + (x0[2] + x0[3]), t1 = (x1[0] + x1[1]) + (x1[2] + x1[3]);
                const float rs = hgrn ? rsqrtf((bj ? t1 : t0) * (1.f / 128.f) + 1e-6f) : rsqrtf((t0 + t1) * (1.f / 256.f) + 1e-6f);
                const size_t idx = (size_t)(u.pm * 256 + rl) * 1024 + j * 256 + bj * 128 + cbase;
                const u32x4 a = *(const u32x4*)(Of + idx), b = *(const u32x4*)(Ob + idx);
                float fa[8], fb[8]; unpack8(a, fa); unpack8(b, fb);
                f32x4 r0, r1;
#pragma unroll
                for (int e = 0; e < 4; ++e) { const float ga = acc[ai][bj][m][0][e], gb = acc[ai][bj][m][1][e];
                    r0[e] = (fa[e] + fb[e]) * rs * g0[e] * (ga * sigmoidf_(ga)); r1[e] = (fa[4 + e] + fb[4 + e]) * rs * g1[e] * (gb * sigmoidf_(gb)); }
                asm volatile("" : "+v"(r0), "+v"(r1));
                *(u32x4*)(A1 + (size_t)(u.pm * 256 + rl) * 2048 + j * 256 + bj * 128 + cbase) = pack8(r0, r1); }
    }
    asm volatile("s_waitcnt lgkmcnt(0)" ::: "memory"); __builtin_amdgcn_s_barrier(); asm volatile("" ::: "memory");
}

__device__ __forceinline__ void epilogue(const Params& p, int phase, const Unit& u, const f32x4 (&acc)[2][2][4][2], int wr, int wc, int fr, int fq, LAS unsigned char* lds) {
    unsigned char* ws = p.ws;
    const int rbase = u.pm * 256 + wr * 64 + fr, cbase = wc * 32 + 8 * fq;
    if (phase == 1 || phase == 2) {
        const int pn = u.pn;
        int kind; unsigned char* dbase = ws; size_t doff; int ld = 1024, col0; float scale = 1.f;
        if (pn < 2) { kind = 0; doff = OFF_Q; ld = 512; col0 = pn * 256; scale = 0.08838834764831845f; }
        else if (pn < 4) { kind = 0; doff = OFF_K; ld = 512; col0 = (pn - 2) * 256; }
        else if (pn < 8) { kind = 0; doff = OFF_V; col0 = (pn - 4) * 256; }
        else if (pn < 10) { kind = 5; doff = OFF_EAF; ld = 512; col0 = (pn - 8) * 256; }
        else if (pn < 12) { kind = 6; doff = OFF_EAB; ld = 512; col0 = (pn - 10) * 256; }
        else if (pn < 16) { kind = 1; doff = OFF_HQ; col0 = (pn - 12) * 256; scale = 0.08838834764831845f; }
        else if (pn < 20) { kind = 3; doff = OFF_EF; col0 = (pn - 16) * 256; }
        else if (pn < 24) { kind = 4; dbase = g_ext; doff = X_EB; col0 = (pn - 20) * 256; }
        else if (pn < 28) { kind = 0; doff = OFF_HV; col0 = (pn - 24) * 256; }
        else if (pn < 32) { gate_norm_epi(p, u, acc, false, pn - 28, lds); return; }
        else if (pn < 36) { gate_norm_epi(p, u, acc, true, pn - 32, lds); return; }
        else if (pn < 40) { kind = 2; doff = OFF_MG; col0 = (pn - 36) * 256; }
        else { kind = 2; doff = OFF_MH; col0 = (pn - 40) * 256; }
        u16* D = (u16*)(dbase + doff);
        if (kind == 0) {
#pragma unroll
            for (int ai = 0; ai < 2; ++ai)
#pragma unroll
                for (int m = 0; m < 4; ++m)
#pragma unroll
                    for (int bj = 0; bj < 2; ++bj) { u16* dst = D + (size_t)(rbase + ai * 128 + m * 16) * ld + col0 + bj * 128 + cbase;
                        *(u32x4*)dst = pack8(acc[ai][bj][m][0] * scale, acc[ai][bj][m][1] * scale); }
        } else if (kind == 1) {
#pragma unroll
            for (int ai = 0; ai < 2; ++ai)
#pragma unroll
                for (int m = 0; m < 4; ++m)
#pragma unroll
                    for (int bj = 0; bj < 2; ++bj) { u16* dst = D + (size_t)(rbase + ai * 128 + m * 16) * ld + col0 + bj * 128 + cbase;
                        f32x4 a = acc[ai][bj][m][0], b = acc[ai][bj][m][1];
#pragma unroll
                        for (int e = 0; e < 4; ++e) { a[e] = a[e] * sigmoidf_(a[e]) * scale; b[e] = b[e] * sigmoidf_(b[e]) * scale; }
                        *(u32x4*)dst = pack8(a, b); }
        } else if (kind == 2) {
#pragma unroll
            for (int ai = 0; ai < 2; ++ai)
#pragma unroll
                for (int m = 0; m < 4; ++m)
#pragma unroll
                    for (int bj = 0; bj < 2; ++bj) { u16* dst = D + (size_t)(rbase + ai * 128 + m * 16) * ld + col0 + bj * 128 + cbase;
                        f32x4 a = acc[ai][bj][m][0], b = acc[ai][bj][m][1];
#pragma unroll
                        for (int e = 0; e < 4; ++e) { a[e] = sigmoidf_(a[e]); b[e] = sigmoidf_(b[e]); }
                        *(u32x4*)dst = pack8(a, b); }
        } else {
            u16* D2 = (u16*)(g_ext + ((kind == 4) ? X_KEB : X_KEF));
            const float* lbp = (const float*)(ws + OFF_LB);
            if (kind == 3) decay_epi<true, false>(acc, D, D2, lbp, ld, col0, rbase, cbase);
            else if (kind == 4) decay_epi<true, true>(acc, D, D2, lbp + 1024, ld, col0, rbase, cbase);
            else if (kind == 5) decay_epi<false, false>(acc, D, D2, p.bias_f, ld, col0, rbase, cbase);
            else decay_epi<false, true>(acc, D, D2, p.bias_b, ld, col0, rbase, cbase);
        }
    } else if (phase == 4) {
        const int g = u.pn >> 2, j = u.pn & 3;
        const u16* Gt = (const u16*)(ws + (g ? OFF_MH : OFF_MG));
        u16* Y = (u16*)(g_ext + X_Y);
#pragma unroll
        for (int ai = 0; ai < 2; ++ai)
#pragma unroll
            for (int m = 0; m < 4; ++m)
#pragma unroll
                for (int bj = 0; bj < 2; ++bj) { const size_t idx = (size_t)(rbase + ai * 128 + m * 16) * 1024 + j * 256 + bj * 128 + cbase;
                    const u32x4 gw = *(const u32x4*)(Gt + idx);
                    f32x4 a = acc[ai][bj][m][0], b = acc[ai][bj][m][1];
                    a[0] *= bflo(gw.x); a[1] *= bfhi(gw.x); a[2] *= bflo(gw.y); a[3] *= bfhi(gw.y);
                    b[0] *= bflo(gw.z); b[1] *= bfhi(gw.z); b[2] *= bflo(gw.w); b[3] *= bfhi(gw.w);
                    if (g) { const u32x4 yw = *(const u32x4*)(Y + idx);
                        a[0] += bflo(yw.x); a[1] += bfhi(yw.x); a[2] += bflo(yw.y); a[3] += bfhi(yw.y);
                        b[0] += bflo(yw.z); b[1] += bfhi(yw.z); b[2] += bflo(yw.w); b[3] += bfhi(yw.w); }
                    *(u32x4*)(Y + idx) = pack8(a, b); }
    } else {
        const float alpha = 1.189207115002721f;
#pragma unroll
        for (int ai = 0; ai < 2; ++ai)
#pragma unroll
            for (int m = 0; m < 4; ++m)
#pragma unroll
                for (int bj = 0; bj < 2; ++bj) { const size_t idx = (size_t)(rbase + ai * 128 + m * 16) * 1024 + u.pn * 256 + bj * 128 + cbase;
                    const f32x4 x0 = *(const f32x4*)(p.x + idx), x1 = *(const f32x4*)(p.x + idx + 4);
                    *(f32x4*)(p.out + idx) = acc[ai][bj][m][0] + alpha * x0; *(f32x4*)(p.out + idx + 4) = acc[ai][bj][m][1] + alpha * x1; }
    }
}

constexpr size_t OFF_XBUF = 61 * MiB + 64 * 1024;
constexpr int LN_CNT_WORD0 = XCD_BAR_WORDS + 1024;
__device__ __forceinline__ void ln_epilogue(const Params& p, const Unit& u, f32x4 (&v)[2][2][4][2], int, int, int, int, LAS unsigned char* lds, int, int) {
    int tidx = threadIdx.x; asm volatile("" : "+v"(tidx));
    const int lane = tidx & 63, wid = __builtin_amdgcn_readfirstlane(tidx >> 6), wr = wid >> 2, wc = wid & 3, fr = lane & 15, fq = lane >> 4;
    LAS f32x2* P = (LAS f32x2*)lds;
    LAS f32x2* S = (LAS f32x2*)(lds + 8192);
    unsigned long long* xbuf = (unsigned long long*)(p.ws + OFF_XBUF);
    unsigned* cnt = (unsigned*)(p.ws + OFF_BAR) + LN_CNT_WORD0 + 64 * u.pm;
    const float alpha = 1.189207115002721f;
    const int rbase = u.pm * 256 + wr * 64 + fr, cbase = u.pn * 256 + wc * 32 + 8 * fq;
#pragma unroll
    for (int ai = 0; ai < 2; ++ai)
#pragma unroll
        for (int m = 0; m < 4; ++m)
#pragma unroll
            for (int bj = 0; bj < 2; ++bj) { const size_t idx = (size_t)(rbase + ai * 128 + m * 16) * 1024 + cbase + bj * 128;
                const f32x4 x0 = *(const f32x4*)(p.x + idx), x1 = *(const f32x4*)(p.x + idx + 4);
                v[ai][bj][m][0] += alpha * x0; v[ai][bj][m][1] += alpha * x1;
                asm volatile("" : "+v"(v[ai][bj][m][0]), "+v"(v[ai][bj][m][1]));
            }
#pragma unroll
    for (int ai = 0; ai < 2; ++ai)
#pragma unroll
        for (int m = 0; m < 4; ++m) {
            float s = 0.f;
#pragma unroll
            for (int bj = 0; bj < 2; ++bj)
#pragma unroll
                for (int n = 0; n < 2; ++n) { const f32x4 x = v[ai][bj][m][n]; s += (x[0] + x[1]) + (x[2] + x[3]); }
            s += __shfl_xor(s, 16); s += __shfl_xor(s, 32);
            const float mw = s * (1.0f / 64.0f); float q = 0.f;
#pragma unroll
            for (int bj = 0; bj < 2; ++bj)
#pragma unroll
                for (int n = 0; n < 2; ++n) { const f32x4 d = v[ai][bj][m][n] - mw; q += (d[0] * d[0] + d[1] * d[1]) + (d[2] * d[2] + d[3] * d[3]); }
            q += __shfl_xor(q, 16); q += __shfl_xor(q, 32);
            if (fq == 0) P[(ai * 128 + wr * 64 + m * 16 + fr) * 4 + wc] = (f32x2){mw, q};
        }
    __syncthreads();
    const int row = wid * 32 + (lane & 31);
    if (lane < 32) {
        const f32x2 a = P[row * 4 + 0], b = P[row * 4 + 1], c = P[row * 4 + 2], d = P[row * 4 + 3];
        const float mt = (a.x + b.x + c.x + d.x) * 0.25f;
        const float da = a.x - mt, db = b.x - mt, dc = c.x - mt, dd = d.x - mt;
        const float m2 = (a.y + b.y) + (c.y + d.y) + 64.0f * ((da * da + db * db) + (dc * dc + dd * dd));
        unsigned long long* slot = xbuf + ((size_t)(u.pm * 256 + row) * 4 + u.pn);
        __hip_atomic_store(slot, ((unsigned long long)__float_as_uint(m2) << 32) | __float_as_uint(mt), __ATOMIC_RELAXED, __HIP_MEMORY_SCOPE_AGENT);
    }
    asm volatile("s_waitcnt vmcnt(0)" ::: "memory");
    if (lane == 0) __hip_atomic_fetch_add(cnt, 1u, __ATOMIC_RELAXED, __HIP_MEMORY_SCOPE_AGENT);
    if (wid == 0) {
        unsigned sp = 0;
        while ((unsigned)__builtin_amdgcn_readfirstlane(__hip_atomic_load(cnt, __ATOMIC_RELAXED, __HIP_MEMORY_SCOPE_AGENT)) < 32u) { __builtin_amdgcn_s_sleep(2); if (++sp > (1u << 20)) break; }
        __builtin_amdgcn_fence(__ATOMIC_ACQUIRE, "agent");
    }
    asm volatile("s_waitcnt vmcnt(0) lgkmcnt(0)" ::: "memory");
    __syncthreads();
    if (lane < 32) {
        const unsigned long long* slot = xbuf + (size_t)(u.pm * 256 + row) * 4; float mt[4], m2[4]; float ms = 0.f;
#pragma unroll
        for (int t = 0; t < 4; ++t) { const unsigned long long w = __hip_atomic_load(slot + t, __ATOMIC_RELAXED, __HIP_MEMORY_SCOPE_AGENT); mt[t] = __uint_as_float((unsigned)w); m2[t] = __uint_as_float((unsigned)(w >> 32)); ms += mt[t]; }
        const float mean = ms * 0.25f; float q = 0.f;
#pragma unroll
        for (int t = 0; t < 4; ++t) { const float dm = mt[t] - mean; q += m2[t] + 256.0f * dm * dm; }
        S[row] = (f32x2){mean, 1.0f / sqrtf(q * (1.0f / 1024.0f) + 1e-5f)};
    }
    __syncthreads();
#pragma unroll
    for (int bj = 0; bj < 2; ++bj) {
        const f32x4 g0 = *(const f32x4*)(p.ln_g + cbase + bj * 128), g1 = *(const f32x4*)(p.ln_g + cbase + bj * 128 + 4);
        const f32x4 b0 = *(const f32x4*)(p.ln_b + cbase + bj * 128), b1 = *(const f32x4*)(p.ln_b + cbase + bj * 128 + 4);
#pragma unroll
        for (int ai = 0; ai < 2; ++ai)
#pragma unroll
            for (int m = 0; m < 4; ++m) { const int rl = ai * 128 + wr * 64 + m * 16 + fr; const f32x2 st = S[rl];
                const size_t idx = (size_t)(u.pm * 256 + rl) * 1024 + cbase + bj * 128;
                *(f32x4*)(p.out + idx) = (v[ai][bj][m][0] - st.x) * st.y * g0 + b0;
                *(f32x4*)(p.out + idx + 4) = (v[ai][bj][m][1] - st.x) * st.y * g1 + b1; }
    }
}

__device__ __forceinline__ void gemm_phase(const Params& p, LAS unsigned char* lds, const Sched& S, int lda, int ldb, int K) {
    int tid = threadIdx.x; asm volatile("" : "+v"(tid));
    const int wid = __builtin_amdgcn_readfirstlane(tid >> 6), lane = tid & 63, wr = wid >> 2, wc = wid & 3, fr = lane & 15, fq = lane >> 4;
    const int nt = K / BK;
    unsigned voffA[2], voffB[2];
#pragma unroll
    for (int i = 0; i < 2; ++i) { int R, C; stage_rc(tid * 16 + i * 8192, R, C); const int Rb = (R & ~31) + perm32(R & 31);
        voffA[i] = (unsigned)(R * lda + C) * 2u; voffB[i] = (unsigned)(Rb * ldb + C) * 2u; }
    const size_t kstep = (size_t)(BK * 2);
    const size_t hstepA = (size_t)HALF * lda * 2, hstepB = (size_t)HALF * ldb * 2;
    const unsigned ldsw = (unsigned)wid * 1024u;
    const int aoff = lds_byte(wr * 64 + fr, fq * 8), boff = lds_byte(wc * 32 + fr, fq * 8);
#define G_SA(b, h) (((b) * 2 + (h)) * HTB)
#define G_SB(b, h) ((4 + (b) * 2 + (h)) * HTB)
#define G_STAGE(bufoff, gbase, voff) do { _Pragma("unroll") for (int _i = 0; _i < 2; ++_i) \
        __builtin_amdgcn_global_load_lds((const unsigned*)((const char*)(gbase) + (voff)[_i]), (LAS unsigned*)(lds + (bufoff) + ldsw + _i * 8192), 16, 0, 0); } while (0)
#define G_LDA(dst, b, h) do { _Pragma("unroll") for (int m = 0; m < 4; ++m) _Pragma("unroll") for (int k = 0; k < 2; ++k) dst[m][k] = *(const LAS bf16x8*)(lds + G_SA(b, h) + aoff + m * 2048 + k * 1024); } while (0)
#define G_LDB(dst, b, h) do { _Pragma("unroll") for (int n = 0; n < 2; ++n) _Pragma("unroll") for (int k = 0; k < 2; ++k) dst[n][k] = *(const LAS bf16x8*)(lds + G_SB(b, h) + boff + n * 2048 + k * 1024); } while (0)
#define G_MMA(ai, bj, At, Bt) do { __builtin_amdgcn_s_setprio(1); _Pragma("unroll") for (int m = 0; m < 4; ++m) _Pragma("unroll") for (int n = 0; n < 2; ++n) _Pragma("unroll") for (int k = 0; k < 2; ++k) \
        acc[ai][bj][m][n] = __builtin_amdgcn_mfma_f32_16x16x32_bf16(Bt[n][k], At[m][k], acc[ai][bj][m][n], 0, 0, 0); __builtin_amdgcn_s_setprio(0); } while (0)
#define G_WAIT_V(n) asm volatile("s_waitcnt vmcnt(" #n ")" ::: "memory")
#define G_WAIT_L(n) asm volatile("s_waitcnt lgkmcnt(" #n ")" ::: "memory")
#define G_BAR __builtin_amdgcn_s_barrier()
#define G_SCHED __builtin_amdgcn_sched_barrier(0)
    Unit cur, nxt; int ui = 0;
    if (!S.next(0, cur)) return;
    f32x4 acc[2][2][4][2];
#pragma unroll
    for (int a = 0; a < 2; ++a)
#pragma unroll
        for (int b = 0; b < 2; ++b)
#pragma unroll
            for (int m = 0; m < 4; ++m)
#pragma unroll
                for (int n = 0; n < 2; ++n) acc[a][b][m][n] = (f32x4){0.f, 0.f, 0.f, 0.f};
    bf16x8 At[4][2], B0[2][2], B1[2][2];
    const char* cA = cur.a; const char* cB = cur.b;
    G_STAGE(G_SB(0, 0), cB, voffB); G_STAGE(G_SB(0, 1), cB + hstepB, voffB); G_STAGE(G_SA(0, 0), cA, voffA); G_STAGE(G_SA(0, 1), cA + hstepA, voffA);
    if (wr == 1) G_BAR;
    G_WAIT_V(2); G_BAR;
    G_STAGE(G_SB(1, 0), cB + kstep, voffB); G_STAGE(G_SA(1, 0), cA + kstep, voffA); G_STAGE(G_SB(1, 1), cB + hstepB + kstep, voffB);
    G_WAIT_V(6); G_BAR;
    for (;;) {
        const bool has_next = S.next(ui + 1, nxt);
        const char* nA = has_next ? nxt.a : cA; const char* nB = has_next ? nxt.b : cB;
        for (int t = 0; t < nt; t += 2) {
            const bool last = (t == nt - 2);
            const char* a1 = cA + (size_t)(t + 1) * kstep;
            const char* a2 = last ? nA : cA + (size_t)(t + 2) * kstep; const char* b2 = last ? nB : cB + (size_t)(t + 2) * kstep;
            const char* a3 = a2 + kstep; const char* b3 = b2 + kstep;
            G_LDB(B0, 0, 0); G_LDB(B1, 0, 1); G_SCHED; G_LDA(At, 0, 0); G_STAGE(G_SA(1, 1), a1 + hstepA, voffA);
            G_WAIT_V(8); G_WAIT_L(0); G_BAR; G_MMA(0, 0, At, B0); G_MMA(0, 1, At, B1); G_BAR; G_SCHED;
            G_LDA(At, 0, 1); G_STAGE(G_SB(0, 0), b2, voffB); G_STAGE(G_SB(0, 1), b2 + hstepB, voffB); G_STAGE(G_SA(0, 0), a2, voffA);
            G_WAIT_V(8); G_WAIT_L(0); G_BAR; G_MMA(1, 0, At, B0); G_MMA(1, 1, At, B1); G_BAR; G_SCHED;
            G_LDB(B0, 1, 0); G_LDB(B1, 1, 1); G_SCHED; G_LDA(At, 1, 0); G_STAGE(G_SA(0, 1), a2 + hstepA, voffA);
            G_WAIT_V(8); G_WAIT_L(0); G_BAR; G_MMA(0, 0, At, B0); G_MMA(0, 1, At, B1); G_BAR; G_SCHED;
            G_LDA(At, 1, 1); G_STAGE(G_SB(1, 0), b3, voffB); G_STAGE(G_SB(1, 1), b3 + hstepB, voffB); G_STAGE(G_SA(1, 0), a3, voffA);
            G_WAIT_V(8); G_WAIT_L(0); G_BAR; G_MMA(1, 0, At, B0); G_MMA(1, 1, At, B1); G_BAR; G_SCHED;
        }
        if (wr == 0) G_BAR;
        if (S.phase != 5) epilogue(p, S.phase, cur, acc, wr, wc, fr, fq, lds);
        if (!has_next) break;
#pragma unroll
        for (int a = 0; a < 2; ++a)
#pragma unroll
            for (int b = 0; b < 2; ++b)
#pragma unroll
                for (int m = 0; m < 4; ++m)
#pragma unroll
                    for (int n = 0; n < 2; ++n) acc[a][b][m][n] = (f32x4){0.f, 0.f, 0.f, 0.f};
        cur = nxt; cA = nA; cB = nB; ++ui;
        if (wr == 1) G_BAR;
    }
    G_WAIT_V(0);
    G_BAR;
    if (S.phase == 5) ln_epilogue(p, cur, acc, wr, wc, fr, fq, lds, wid, lane);
}

__device__ __forceinline__ void phase0(const Params& p, LAS unsigned char* lds) {
    const int tid = threadIdx.x;
    const size_t gtid = (size_t)blockIdx.x * 512 + tid, gsz = (size_t)gridDim.x * 512;
    {
        const f32x4* x4 = (const f32x4*)p.x; u32x4* xb = (u32x4*)(p.ws + OFF_XB);
        const size_t n8 = (size_t)MTOK * DM / 8;
        for (size_t i = gtid; i < n8; i += gsz) { const f32x4 a = x4[2 * i], b = x4[2 * i + 1]; xb[i] = pack8(a, b); }
    }
    if (gtid < 2048) {
        const int d = (int)gtid & 1023; const float* L = (gtid < 1024) ? p.lbl_f : p.lbl_b;
        const float l0 = L[d], l1 = L[1024 + d];
        ((float*)(p.ws + OFF_LB))[gtid] = 1.f / (1.f + expf(l1 - l0));
    }
    LAS float* T = (LAS float*)lds;
    for (int job = blockIdx.x; job < 1408 + 384; job += gridDim.x) {
        const float* src; u16* dst; int ldw, nt64, kt, isin;
        if (job < 1408) { isin = 1; src = p.w_in; ldw = NIN; dst = (u16*)(p.ws + OFF_WINT); nt64 = job >> 3; kt = job & 7; }
        else { const int jj = job - 1408, mat = jj >> 7, r = jj & 127; isin = 0; ldw = 1024; nt64 = r >> 3; kt = r & 7;
            src = mat == 0 ? p.w_gla : (mat == 1 ? p.w_hgrn : p.w_out); dst = (u16*)(p.ws + (mat == 0 ? OFF_WGT : (mat == 1 ? OFF_WHT : OFF_WOT))); }
        const int c = tid & 63, kr = tid >> 6;
        const int m = nt64 * 64 + c;
        int orig = m; int eff = 0;
        if (isin) {
            if (m < 2048) orig = m;
            else if (m < 3072) { eff = 1; orig = m - 2048; }
            else if (m < 7168) orig = m + 32;
            else if (m < 8192) orig = 2048 + (m - 7168);
            else orig = 7200 + (m - 8192);
        }
        if (eff) {
            const int bw = orig >> 9, cc = orig & 511;
            const float* U = bw ? p.up_b : p.up_f;
            float uv[16];
#pragma unroll
            for (int r = 0; r < 16; ++r) uv[r] = U[r * 512 + cc];
            for (int i = 0; i < 16; ++i) { const int k = kr + 8 * i;
                const float* wr_ = src + (size_t)(kt * 128 + k) * ldw + 3072 + bw * 16;
                float s = 0.f;
#pragma unroll
                for (int r = 0; r < 16; ++r) s += wr_[r] * uv[r];
                T[k * 65 + c] = s; }
        } else {
#pragma unroll 4
            for (int i = 0; i < 16; ++i) { const int k = kr + 8 * i;
                T[k * 65 + c] = src[(size_t)(kt * 128 + k) * ldw + orig]; }
        }
        __syncthreads();
        const int rho = tid >> 3, kseg = tid & 7;
        float v[16];
#pragma unroll
        for (int kk = 0; kk < 16; ++kk) v[kk] = T[(kseg * 16 + kk) * 65 + rho];
        u32x4 w0, w1;
        w0.x = pk_bf16(v[0], v[1]); w0.y = pk_bf16(v[2], v[3]); w0.z = pk_bf16(v[4], v[5]); w0.w = pk_bf16(v[6], v[7]);
        w1.x = pk_bf16(v[8], v[9]); w1.y = pk_bf16(v[10], v[11]); w1.z = pk_bf16(v[12], v[13]); w1.w = pk_bf16(v[14], v[15]);
        u16* d = dst + (size_t)(nt64 * 64 + rho) * 1024 + kt * 128 + kseg * 16;
        *(u32x4*)d = w0; *(u32x4*)(d + 8) = w1;
        __syncthreads();
    }
}

constexpr int S_QE = 0, S_KE = 19456, S_V = 38912, S_PP = 48128, S_ST0 = 57344, S_ST1 = 76800, S_DEC = 96256;
constexpr int RS = 304, RV = 144;
typedef short s16x4 __attribute__((ext_vector_type(4)));
#define MFMA16(a, b, c) __builtin_amdgcn_mfma_f32_16x16x32_bf16(a, b, c, 0, 0, 0)

__device__ __forceinline__ bf16x8 tr8(LAS unsigned char* p0, int stride4) {
    const s16x4 a = __builtin_amdgcn_ds_read_tr16_b64_v4i16((LAS s16x4*)p0);
    const s16x4 b = __builtin_amdgcn_ds_read_tr16_b64_v4i16((LAS s16x4*)(p0 + stride4));
    return __builtin_shufflevector(a, b, 0, 1, 2, 3, 4, 5, 6, 7);
}

__device__ __forceinline__ void scan_phase(const Params& p, LAS unsigned char* lds) {
    const int tid = threadIdx.x, w = __builtin_amdgcn_readfirstlane(tid >> 6), lane = tid & 63, fr = lane & 15, fq = lane >> 4;
    const int ti = tid >> 3, ch = tid & 7;
    for (int u = blockIdx.x; u < 256; u += gridDim.x) {
        const int xcd = u & 7, slot = u >> 3;
        const bool isg = slot < 16;
        int bb, hh, dir, e0, ldq;
        const u16 *Qp, *Ep, *Kp, *Vp; u16* Op;
        if (isg) { const int grp = xcd + 8 * (slot >> 2), sl = slot & 3; bb = grp >> 3; hh = (grp >> 1) & 3; dir = grp & 1; e0 = hh * 256 + sl * 64; ldq = 512;
            Qp = (const u16*)(p.ws + OFF_Q); Kp = (const u16*)(p.ws + OFF_K); Ep = (const u16*)(p.ws + (dir ? OFF_EAB : OFF_EAF)); Vp = (const u16*)(p.ws + OFF_V);
            Op = (u16*)((unsigned char*)p.out + (dir ? OFF_OAB : OFF_OAF)); }
        else { const int s = slot - 16, grp = xcd + 8 * (s >> 1), sl = s & 1; bb = grp >> 4; hh = (grp >> 1) & 7; dir = grp & 1; e0 = hh * 128 + sl * 64; ldq = 1024;
            Qp = (const u16*)(p.ws + OFF_HQ); Vp = (const u16*)(p.ws + OFF_HV);
            Ep = dir ? (const u16*)(g_ext + X_EB) : (const u16*)(p.ws + OFF_EF); Kp = (const u16*)(g_ext + (dir ? X_KEB : X_KEF));
            Op = (u16*)(g_ext + (dir ? X_OHB : X_OHF)); }
        const int qc = hh * 128 + ch * 8;
        const int tb = bb * SEQ, sgn = dir ? -1 : 1;
        for (int i = tid; i < 19456 / 4; i += 512) *(LAS unsigned*)(lds + S_ST0 + i * 4) = 0u;
        f32x4 sacc[4];
#pragma unroll
        for (int ne = 0; ne < 4; ++ne) sacc[ne] = (f32x4){0.f, 0.f, 0.f, 0.f};
        u32x4 rq[2], re[2], rk[2], rv;
        {
            const size_t t = (size_t)(tb + (dir ? SEQ - 1 : 0) + sgn * ti);
            rq[0] = *(const u32x4*)(Qp + t * ldq + qc); rq[1] = *(const u32x4*)(Qp + t * ldq + qc + 64);
            re[0] = *(const u32x4*)(Ep + t * ldq + qc); re[1] = *(const u32x4*)(Ep + t * ldq + qc + 64);
            rk[0] = *(const u32x4*)(Kp + t * ldq + qc); rk[1] = *(const u32x4*)(Kp + t * ldq + qc + 64);
            rv = *(const u32x4*)(Vp + t * 1024 + e0 + ch * 8);
        }
        __syncthreads();
        for (int c = 0; c < 64; ++c) {
            const int base = tb + (dir ? SEQ - 1 - 64 * c : 64 * c);
#pragma unroll
            for (int hf = 0; hf < 2; ++hf) {
                float q[8], e[8];
                unpack8(rq[hf], q); unpack8(re[hf], e);
                f32x4 a0, a1;
#pragma unroll
                for (int x = 0; x < 4; ++x) { a0[x] = q[x] * e[x]; a1[x] = q[4 + x] * e[4 + x]; }
                *(LAS u32x4*)(lds + S_QE + ti * RS + ch * 16 + hf * 128) = pack8(a0, a1);
                if (isg) { float k[8]; unpack8(rk[hf], k);
#pragma unroll
                    for (int x = 0; x < 4; ++x) { a0[x] = k[x] * __builtin_amdgcn_rcpf(e[x]); a1[x] = k[4 + x] * __builtin_amdgcn_rcpf(e[4 + x]); }
                    *(LAS u32x4*)(lds + S_KE + ti * RS + ch * 16 + hf * 128) = pack8(a0, a1); }
                else *(LAS u32x4*)(lds + S_KE + ti * RS + ch * 16 + hf * 128) = rk[hf];
                if (ti == 63) { *(LAS f32x4*)(lds + S_DEC + (ch * 8 + hf * 64) * 4) = (f32x4){e[0], e[1], e[2], e[3]}; *(LAS f32x4*)(lds + S_DEC + (ch * 8 + hf * 64 + 4) * 4) = (f32x4){e[4], e[5], e[6], e[7]}; }
            }
            *(LAS u32x4*)(lds + S_V + ti * RV + ch * 16) = rv;
            if (c < 63) {
                const size_t t = (size_t)(tb + (dir ? SEQ - 1 - 64 * (c + 1) : 64 * (c + 1)) + sgn * ti);
                rq[0] = *(const u32x4*)(Qp + t * ldq + qc); rq[1] = *(const u32x4*)(Qp + t * ldq + qc + 64);
                re[0] = *(const u32x4*)(Ep + t * ldq + qc); re[1] = *(const u32x4*)(Ep + t * ldq + qc + 64);
                rk[0] = *(const u32x4*)(Kp + t * ldq + qc); rk[1] = *(const u32x4*)(Kp + t * ldq + qc + 64);
                rv = *(const u32x4*)(Vp + t * 1024 + e0 + ch * 8);
            }
            __syncthreads();
            bf16x8 bqs[4], vfr[2][2];
            {
                const int mi = w >> 1, njb = (w & 1) * 2;
                f32x4 sc[2]; sc[0] = (f32x4){0.f, 0.f, 0.f, 0.f}; sc[1] = sc[0];
#pragma unroll
                for (int kk = 0; kk < 4; ++kk) { const bf16x8 bq = *(const LAS bf16x8*)(lds + S_QE + (16 * mi + fr) * RS + (32 * kk + 8 * fq) * 2); bqs[kk] = bq;
#pragma unroll
                    for (int n2 = 0; n2 < 2; ++n2) if (njb + n2 <= mi) {
                        const bf16x8 ak = *(const LAS bf16x8*)(lds + S_KE + (16 * (njb + n2) + fr) * RS + (32 * kk + 8 * fq) * 2); sc[n2] = MFMA16(ak, bq, sc[n2]); } }
                const int i = 16 * mi + fr;
#pragma unroll
                for (int n2 = 0; n2 < 2; ++n2) { const int j0 = 16 * (njb + n2) + 4 * fq;
                    const float m0 = (i >= j0) ? sc[n2][0] : 0.f, m1 = (i >= j0 + 1) ? sc[n2][1] : 0.f, m2 = (i >= j0 + 2) ? sc[n2][2] : 0.f, m3 = (i >= j0 + 3) ? sc[n2][3] : 0.f;
                    *(LAS u32x2*)(lds + S_PP + i * RV + j0 * 2) = (u32x2){pk_bf16(m0, m1), pk_bf16(m2, m3)}; }
            }
            const int stold = (c & 1) ? S_ST1 : S_ST0, stnew = (c & 1) ? S_ST0 : S_ST1;
            {
#pragma unroll
                for (int kk = 0; kk < 2; ++kk) {
                    const int jr = 32 * kk + 8 * fq + (fr >> 2);
                    const bf16x8 a = tr8(lds + S_KE + jr * RS + (16 * w + 4 * (fr & 3)) * 2, 4 * RS);
#pragma unroll
                    for (int ne = 0; ne < 4; ++ne) { const bf16x8 bv = tr8(lds + S_V + jr * RV + (16 * ne + 4 * (fr & 3)) * 2, 4 * RV); sacc[ne] = MFMA16(a, bv, sacc[ne]);
                        if ((w & 1) == (ne >> 1)) vfr[kk][ne & 1] = bv; } }
                const f32x4 dec = *(const LAS f32x4*)(lds + S_DEC + (16 * w + 4 * fq) * 4);
#pragma unroll
                for (int ne = 0; ne < 4; ++ne) { sacc[ne] = sacc[ne] * dec;
                    *(LAS u32x2*)(lds + stnew + (16 * ne + fr) * RS + (16 * w + 4 * fq) * 2) = (u32x2){pk_bf16(sacc[ne][0], sacc[ne][1]), pk_bf16(sacc[ne][2], sacc[ne][3])}; }
            }
            __syncthreads();
            {
                const int mi = w >> 1, neb = (w & 1) * 2;
                f32x4 oa[2]; oa[0] = (f32x4){0.f, 0.f, 0.f, 0.f}; oa[1] = oa[0];
#pragma unroll
                for (int kk = 0; kk < 4; ++kk) { const bf16x8 b = bqs[kk];
#pragma unroll
                    for (int n2 = 0; n2 < 2; ++n2) { const bf16x8 a = *(const LAS bf16x8*)(lds + stold + (16 * (neb + n2) + fr) * RS + (32 * kk + 8 * fq) * 2); oa[n2] = MFMA16(a, b, oa[n2]); } }
#pragma unroll
                for (int kk = 0; kk < 2; ++kk) { const bf16x8 b = *(const LAS bf16x8*)(lds + S_PP + (16 * mi + fr) * RV + (32 * kk + 8 * fq) * 2);
#pragma unroll
                    for (int n2 = 0; n2 < 2; ++n2) { oa[n2] = MFMA16(vfr[kk][n2], b, oa[n2]); } }
                u16* optr = Op + (size_t)(base + sgn * (16 * mi + fr)) * 1024 + e0 + 16 * neb + 4 * fq;
                *(u32x2*)optr = (u32x2){pk_bf16(oa[0][0], oa[0][1]), pk_bf16(oa[0][2], oa[0][3])};
                *(u32x2*)(optr + 16) = (u32x2){pk_bf16(oa[1][0], oa[1][1]), pk_bf16(oa[1][2], oa[1][3])};
            }
            __syncthreads();
        }
    }
}

#define XB_TMO      128
#define XB_XCNT(j)  (256  + 64 * (j))
#define XB_XSUB(j)  (1280 + 64 * (j))
#define XB_XGEN(j)  (2304 + 64 * (j))
#define XB_TOP      3328
#define XB_TOPGEN   3392
#define XB_SPIN_CAP (1u << 18)
__device__ __forceinline__ unsigned xb_ld(unsigned* p)              { return __hip_atomic_load(p, __ATOMIC_RELAXED, __HIP_MEMORY_SCOPE_AGENT); }
__device__ __forceinline__ unsigned xb_add(unsigned* p, unsigned v) { return __hip_atomic_fetch_add(p, v, __ATOMIC_RELAXED, __HIP_MEMORY_SCOPE_AGENT); }
__device__ __forceinline__ unsigned xb_xcc_id() { return (unsigned)__builtin_amdgcn_s_getreg((3 << 11) | 20) & 0xFu; }
#define XB_SPIN(cond, bar) do { unsigned _sp = 0; while (cond) { __builtin_amdgcn_s_sleep(1); \
    if ((++_sp & 255u) == 0u) { if (xb_ld(&(bar)[XB_TMO])) break; if (_sp > XB_SPIN_CAP) { atomicAdd(&(bar)[XB_TMO], 1u); break; } } } } while (0)
struct XcdBarrier { unsigned* bar; unsigned x; volatile LAS unsigned* st; };
__device__ __forceinline__ XcdBarrier xcd_barrier_post(unsigned* bar, volatile LAS unsigned* st) {
    XcdBarrier b; b.bar = bar; b.x = xb_xcc_id(); b.st = st;
    if (threadIdx.x == 0) (void)xb_add(&bar[XB_XCNT(b.x)], 1u);
    return b;
}
__device__ __forceinline__ void xcd_barrier_complete(unsigned* bar, unsigned x, unsigned& nloc, unsigned& nx) {
    const unsigned G = gridDim.x * gridDim.y * gridDim.z;
    unsigned sum, cnt, mine, sp = 0u;
    for (;;) {
        sum = 0u; cnt = 0u; mine = 0u;
#pragma unroll
        for (unsigned j = 0; j < 16; ++j) { const unsigned c = xb_ld(&bar[XB_XCNT(j)]); sum += c; cnt += (c > 0u) ? 1u : 0u; mine = (j == x) ? c : mine; }
        if (sum == G) break;
        __builtin_amdgcn_s_sleep(1);
        if ((++sp & 255u) == 0u) { if (xb_ld(&bar[XB_TMO])) break; if (sp > XB_SPIN_CAP) { atomicAdd(&bar[XB_TMO], 1u); break; } }
    }
    nloc = mine > 0u ? mine : 1u; nx = cnt > 0u ? cnt : 1u;
}
__device__ __forceinline__ void xcd_barrier(const XcdBarrier& b) {
    asm volatile("s_waitcnt vmcnt(0)" ::: "memory");
    __syncthreads();
    if (threadIdx.x == 0) {
        unsigned* bar = b.bar;
        __builtin_amdgcn_s_waitcnt(0);
        unsigned nloc = b.st[0], nx = b.st[1];
        if (nloc == 0u) { xcd_barrier_complete(bar, b.x, nloc, nx); b.st[0] = nloc; b.st[1] = nx; }
        const unsigned old = xb_add(&bar[XB_XSUB(b.x)], 1u);
        const unsigned gen = old / nloc;
        if (old + 1u == (gen + 1u) * nloc) {
            __builtin_amdgcn_fence(__ATOMIC_RELEASE, "agent");
            asm volatile("s_waitcnt vmcnt(0)" ::: "memory");
            const unsigned og = xb_add(&bar[XB_TOP], 1u);
            const unsigned tg = og / nx;
            if (og + 1u == (tg + 1u) * nx) xb_add(&bar[XB_TOPGEN], 1u);
            else XB_SPIN(xb_ld(&bar[XB_TOPGEN]) == tg, bar);
            __builtin_amdgcn_fence(__ATOMIC_ACQUIRE, "agent");
            xb_add(&bar[XB_XGEN(b.x)], 1u);
            asm volatile("s_waitcnt vmcnt(0)" ::: "memory");
        } else {
            XB_SPIN(xb_ld(&bar[XB_XGEN(b.x)]) == gen, bar);
            __builtin_amdgcn_fence(__ATOMIC_ACQUIRE, "agent");
            asm volatile("s_waitcnt vmcnt(0)" ::: "memory");
        }
    }
    __syncthreads();
}

__global__ void __launch_bounds__(512) mega(Params p) {
    extern __shared__ __attribute__((aligned(16))) unsigned char lds_raw[];
    LAS unsigned char* lds = (LAS unsigned char*)lds_raw;
    cg::grid_group grid = cg::this_grid();
    volatile LAS unsigned* xst = (volatile LAS unsigned*)(lds + 131072);
    if (threadIdx.x == 0) { xst[0] = 0u; xst[1] = 0u; xst[2] = 0u; xst[3] = 0u; }
    __syncthreads();
    const XcdBarrier xb = xcd_barrier_post((unsigned*)(p.ws + OFF_BAR), xst);
    Sched S; S.G = gridDim.x; S.c = blockIdx.x; S.ws = p.ws;
    if (p.ws == nullptr) grid.sync();
    phase0(p, lds);
    xcd_barrier(xb);
    S.phase = 1; S.nN = 28; S.ntiles = 64 * 28; S.nsub = 1;
    gemm_phase(p, lds, S, 1024, 1024, 1024);
    xcd_barrier(xb);
    scan_phase(p, lds);
    xcd_barrier(xb);
    S.phase = 2; S.nN = 16; S.ntiles = 64 * 16; S.nsub = 1;
    gemm_phase(p, lds, S, 1024, 1024, 1024);
    xcd_barrier(xb);
    S.phase = 4; S.nN = 4; S.ntiles = 256; S.nsub = 2;
    gemm_phase(p, lds, S, 2048, 1024, 1024);
    xcd_barrier(xb);
    S.phase = 5; S.nN = 4; S.ntiles = 256; S.nsub = 1;
    gemm_phase(p, lds, S, 1024, 1024, 1024);
}

extern "C" void kernel_launch(void* const* d_in, const int* in_sizes, int n_in,
                              void* d_out, int out_size, void* d_ws, size_t ws_size,
                              hipStream_t stream) {
    constexpr size_t kDynLds = 131088 + 8192;
    static int grid_blocks = 0;
    if (!grid_blocks) {
        int dev = 0, cus = 0, per_cu = 0;
        (void)hipGetDevice(&dev);
        (void)hipDeviceGetAttribute(&cus, hipDeviceAttributeMultiprocessorCount, dev);
        (void)hipFuncSetAttribute((const void*)mega, hipFuncAttributeMaxDynamicSharedMemorySize, (int)kDynLds);
        (void)hipOccupancyMaxActiveBlocksPerMultiprocessor(&per_cu, mega, 512, kDynLds);
        if (per_cu < 1) per_cu = 1;
        if (per_cu > 1) per_cu = 1;
        grid_blocks = cus * per_cu;
    }
    Params p{};
    p.x = (const float*)d_in[0]; p.w_in = (const float*)d_in[1]; p.up_f = (const float*)d_in[2]; p.bias_f = (const float*)d_in[3];
    p.up_b = (const float*)d_in[4]; p.bias_b = (const float*)d_in[5]; p.gla_g = (const float*)d_in[6]; p.lbl_f = (const float*)d_in[7];
    p.lbl_b = (const float*)d_in[8]; p.hg_g = (const float*)d_in[9]; p.w_gla = (const float*)d_in[10]; p.w_hgrn = (const float*)d_in[11];
    p.w_out = (const float*)d_in[12]; p.ln_g = (const float*)d_in[13]; p.ln_b = (const float*)d_in[14];
    p.out = (float*)d_out; p.ws = (unsigned char*)d_ws;
    (void)hipMemsetAsync((unsigned char*)d_ws + OFF_BAR, 0, (XCD_BAR_WORDS + 1024 + 64 * 64) * sizeof(unsigned), stream);
    void* args[] = {&p};
    hipError_t e = hipLaunchCooperativeKernel((void*)mega, dim3(grid_blocks), dim3(512), args, kDynLds, stream);
    if (e != hipSuccess) fprintf(stderr, "cooperative launch failed: %s (grid %d)\n", hipGetErrorString(e), grid_blocks);
}
```

```cpp
#include <hip/hip_runtime.h>
#include <hip/hip_cooperative_groups.h>
#include <cstdio>
#include <cstdint>
namespace cg = cooperative_groups;

#define LAS __attribute__((address_space(3)))
typedef unsigned short u16;
typedef short bf16x8 __attribute__((ext_vector_type(8)));
typedef float f32x4 __attribute__((ext_vector_type(4)));
typedef float f32x2 __attribute__((ext_vector_type(2)));
typedef unsigned u32x4 __attribute__((ext_vector_type(4)));
typedef unsigned u32x2 __attribute__((ext_vector_type(2)));
typedef _Float16 h16x2 __attribute__((ext_vector_type(2)));

constexpr int SEQ = 4096, MTOK = 16384, DM = 1024, NIN = 10272;
constexpr size_t MiB = 1024ull * 1024ull;
constexpr size_t OFF_BAR = 61 * MiB;
#define XCD_BAR_WORDS 3456
constexpr size_t OFF_XB = 0, OFF_WINT = 32 * MiB, OFF_WGT = 54 * MiB, OFF_WHT = 56 * MiB, OFF_WOT = 58 * MiB, OFF_LB = 60 * MiB;
constexpr size_t OFF_Q = 64 * MiB, OFF_K = 80 * MiB, OFF_V = 96 * MiB, OFF_EAF = 128 * MiB, OFF_EAB = 144 * MiB, OFF_HQ = 160 * MiB, OFF_HV = 192 * MiB, OFF_EF = 224 * MiB;
constexpr size_t OFF_GATEA = 64 * MiB, OFF_HGATE = 96 * MiB, OFF_MG = 128 * MiB, OFF_MH = 160 * MiB, OFF_A1 = 192 * MiB;
constexpr size_t X_KEF = 0, X_EB = 32 * MiB, X_KEB = 64 * MiB, X_OHF = 96 * MiB, X_OHB = 128 * MiB, X_Y = 0;
__device__ __attribute__((aligned(256))) unsigned char g_ext[160 * MiB];
constexpr size_t OFF_OAF = 0, OFF_OAB = 32 * MiB;

struct Params {
    const float *x, *w_in, *up_f, *bias_f, *up_b, *bias_b, *gla_g, *lbl_f, *lbl_b, *hg_g, *w_gla, *w_hgrn, *w_out, *ln_g, *ln_b;
    float* out;
    unsigned char* ws;
};

typedef __bf16 bf16x2_t __attribute__((ext_vector_type(2)));
__device__ __forceinline__ unsigned pk_bf16(float lo, float hi) { const f32x2 v = {lo, hi}; return __builtin_bit_cast(unsigned, __builtin_convertvector(v, bf16x2_t)); }
__device__ __forceinline__ float bflo(unsigned w) { return __uint_as_float(w << 16); }
__device__ __forceinline__ float bfhi(unsigned w) { return __uint_as_float(w & 0xffff0000u); }
__device__ __forceinline__ float sigmoidf_(float v) { return __builtin_amdgcn_rcpf(1.f + __expf(-v)); }
__device__ __forceinline__ unsigned pk_h16(float lo, float hi) { h16x2 h; h.x = (_Float16)lo; h.y = (_Float16)hi; return __builtin_bit_cast(unsigned, h); }

template <int CTRL> __device__ __forceinline__ float dppf(float old, float v) { return __int_as_float(__builtin_amdgcn_update_dpp(__float_as_int(old), __float_as_int(v), CTRL, 0xf, 0xf, false)); }

constexpr int BM = 256, BK = 64, HALF = 128, HTB = HALF * BK * 2;
__device__ __forceinline__ int lds_byte(int r, int c) { const int st = (r >> 4) * 2 + (c >> 5), rr = r & 15, cc = c & 31, ob = rr * 64 + cc * 2; return st * 1024 + (ob ^ (((ob >> 9) & 1) << 5)); }
__device__ __forceinline__ void stage_rc(int b, int& R, int& C) { const int st = b / 1024, sb = b % 1024, swz = sb ^ (((sb >> 9) & 1) << 5); R = (st >> 1) * 16 + swz / 64; C = (st & 1) * 32 + (swz % 64) / 2; }
__device__ __forceinline__ int perm32(int rho) { const int n = rho >> 4, i = rho & 15; return 8 * (i >> 2) + 4 * n + (i & 3); }

struct Unit { const char* a; const char* b; int pm; int pn; };

struct Sched {
    int phase;
    int nN, ntiles, nsub, G, c;
    const unsigned char* ws;
    __device__ __forceinline__ bool next(int ui, Unit& u) const {
        const int tile = (nsub == 2) ? (ui >> 1) : ui, g = (nsub == 2) ? (ui & 1) : 0;
        const long L = (long)tile * G + c;
        if (L >= ntiles) return false;
        int wgid = (int)L;
        { const int q = ntiles / 8, r = ntiles % 8, xcd = wgid % 8, off = wgid / 8; wgid = (xcd < r ? xcd * (q + 1) : r * (q + 1) + (xcd - r) * q) + off; }
        const int nM = 64, nig = 8 * nN, gid = wgid / nig, fm = gid * 8, gsz = (nM - fm) < 8 ? (nM - fm) : 8;
        const int pm = fm + ((wgid % nig) % gsz), j = (wgid % nig) / gsz;
        u.pm = pm;
        if (phase == 1 || phase == 2) { const int pn = (phase == 1) ? j : j + 28; u.pn = pn;
            u.a = (const char*)ws + OFF_XB + (size_t)pm * 256 * 1024 * 2; u.b = (const char*)ws + OFF_WINT + (size_t)pn * 256 * 1024 * 2; }
        else if (phase == 4) { u.pn = j + 4 * g;
            u.a = (const char*)ws + OFF_A1 + (size_t)pm * 256 * 2048 * 2 + (size_t)g * 1024 * 2; u.b = (const char*)ws + (g ? OFF_WHT : OFF_WGT) + (size_t)j * 256 * 1024 * 2; }
        else { u.pn = j;
            u.a = (const char*)g_ext + X_Y + (size_t)pm * 256 * 1024 * 2; u.b = (const char*)ws + OFF_WOT + (size_t)j * 256 * 1024 * 2; }
        return true;
    }
};

__device__ __forceinline__ void unpack8(const u32x4& w, float (&f)[8]) {
    f[0] = bflo(w.x); f[1] = bfhi(w.x); f[2] = bflo(w.y); f[3] = bfhi(w.y); f[4] = bflo(w.z); f[5] = bfhi(w.z); f[6] = bflo(w.w); f[7] = bfhi(w.w);
}
__device__ __forceinline__ u32x4 pack8(const f32x4& v0, const f32x4& v1) { u32x4 w; w.x = pk_bf16(v0[0], v0[1]); w.y = pk_bf16(v0[2], v0[3]); w.z = pk_bf16(v1[0], v1[1]); w.w = pk_bf16(v1[2], v1[3]); return w; }

template <bool HG, bool BWD>
__device__ __forceinline__ void decay_epi(const f32x4 (&acc)[2][2][4][2], u16* D, u16* D2, const float* cvec, int ld, int col0, int rbase, int cbase) {
    int tidx = threadIdx.x; asm volatile("" : "+v"(tidx));
    const int lane = tidx & 63;
    const int srcl = BWD ? (lane & 48) : ((lane & 48) | 15);
#pragma unroll
    for (int bj = 0; bj < 2; ++bj)
#pragma unroll
        for (int n = 0; n < 2; ++n) {
            const int cc = col0 + bj * 128 + cbase + 4 * n;
            const f32x4 cv = *(const f32x4*)(cvec + cc);
#pragma unroll
            for (int ai = 0; ai < 2; ++ai) {
                f32x4 sv[4], omf[4];
#pragma unroll
                for (int m = 0; m < 4; ++m)
#pragma unroll
                    for (int e = 0; e < 4; ++e) { const float a = acc[ai][bj][m][n][e];
                        if (HG) { const float f = cv[e] + (1.f - cv[e]) * sigmoidf_(a); sv[m][e] = f; omf[m][e] = 1.f - f; }
                        else { const float z = a + cv[e]; const float g = (fminf(z, 0.f) - __logf(1.f + __expf(-fabsf(z)))) * 0.0625f; sv[m][e] = g; } }
#pragma unroll
                for (int m = 0; m < 4; ++m)
#pragma unroll
                    for (int e = 0; e < 4; ++e) { float s = sv[m][e];
                        if (HG) { if (BWD) { s *= dppf<0x101>(1.f, s); s *= dppf<0x102>(1.f, s); s *= dppf<0x104>(1.f, s); s *= dppf<0x108>(1.f, s); }
                                  else { s *= dppf<0x111>(1.f, s); s *= dppf<0x112>(1.f, s); s *= dppf<0x114>(1.f, s); s *= dppf<0x118>(1.f, s); } }
                        else { if (BWD) { s += dppf<0x101>(0.f, s); s += dppf<0x102>(0.f, s); s += dppf<0x104>(0.f, s); s += dppf<0x108>(0.f, s); }
                               else { s += dppf<0x111>(0.f, s); s += dppf<0x112>(0.f, s); s += dppf<0x114>(0.f, s); s += dppf<0x118>(0.f, s); } }
                        sv[m][e] = s; }
                __builtin_amdgcn_sched_barrier(0);
#pragma unroll
                for (int e = 0; e < 4; ++e) {
                    float off = HG ? 1.f : 0.f;
#pragma unroll
                    for (int mm = 0; mm < 4; ++mm) { constexpr int dummy = 0; (void)dummy;
                        const int m = BWD ? 3 - mm : mm;
                        const float tot = __shfl(sv[m][e], srcl);
                        if (HG) { sv[m][e] *= off; off *= tot; } else { sv[m][e] += off; off += tot; } }
                }
#pragma unroll
                for (int m = 0; m < 4; ++m) { const unsigned idx = (unsigned)((rbase + ai * 128 + m * 16) * ld + cc);
                    f32x4 e0;
#pragma unroll
                    for (int e = 0; e < 4; ++e) e0[e] = HG ? sv[m][e] : __expf(sv[m][e]);
                    *(u32x2*)(D + idx) = (u32x2){pk_bf16(e0[0], e0[1]), pk_bf16(e0[2], e0[3])};
                    if (HG) { f32x4 k0;
#pragma unroll
                        for (int e = 0; e < 4; ++e) k0[e] = omf[m][e] * __builtin_amdgcn_rcpf(e0[e]);
                        *(u32x2*)(D2 + idx) = (u32x2){pk_bf16(k0[0], k0[1]), pk_bf16(k0[2], k0[3])}; }
                    __builtin_amdgcn_sched_barrier(0); }
                __builtin_amdgcn_sched_barrier(0);
            }
        }
}


constexpr int L_NORMX = 131088;
__device__ __forceinline__ void gate_norm_epi(const Params& p, const Unit& u, const f32x4 (&acc)[2][2][4][2], bool hgrn, int j, LAS unsigned char* lds) {
    int tidx = threadIdx.x; asm volatile("" : "+v"(tidx));
    const int lane = tidx & 63, wid = __builtin_amdgcn_readfirstlane(tidx >> 6), wr = wid >> 2, wc = wid & 3, fr = lane & 15, fq = lane >> 4;
    const u16* Of = hgrn ? (const u16*)(g_ext + X_OHF) : (const u16*)((const unsigned char*)p.out + OFF_OAF);
    const u16* Ob = hgrn ? (const u16*)(g_ext + X_OHB) : (const u16*)((const unsigned char*)p.out + OFF_OAB);
    const float* gain = hgrn ? p.hg_g : p.gla_g;
    u16* A1 = (u16*)(p.ws + OFF_A1) + (hgrn ? 1024 : 0);
    LAS float* X = (LAS float*)(lds + L_NORMX);
    const int rloc = wr * 64 + fr, cbase = wc * 32 + 8 * fq;
#pragma unroll
    for (int ai = 0; ai < 2; ++ai)
#pragma unroll
        for (int m = 0; m < 4; ++m) {
            float ss[2];
#pragma unroll
            for (int bj = 0; bj < 2; ++bj) { const size_t idx = (size_t)(u.pm * 256 + rloc + ai * 128 + m * 16) * 1024 + j * 256 + bj * 128 + cbase;
                const u32x4 a = *(const u32x4*)(Of + idx), b = *(const u32x4*)(Ob + idx);
                float fa[8], fb[8]; unpack8(a, fa); unpack8(b, fb);
                float s = 0.f;
#pragma unroll
                for (int e = 0; e < 8; ++e) { const float o = fa[e] + fb[e]; s += o * o; }
                s += __shfl_xor(s, 16); s += __shfl_xor(s, 32);
                ss[bj] = s; }
            asm volatile("" : "+v"(ss[0]), "+v"(ss[1]));
            if (fq == 0) { X[((rloc + ai * 128 + m * 16) * 2 + 0) * 4 + wc] = ss[0]; X[((rloc + ai * 128 + m * 16) * 2 + 1) * 4 + wc] = ss[1]; }
        }
    asm volatile("s_waitcnt lgkmcnt(0)" ::: "memory"); __builtin_amdgcn_s_barrier(); asm volatile("" ::: "memory");
#pragma unroll
    for (int bj = 0; bj < 2; ++bj) {
        const f32x4 g0 = *(const f32x4*)(gain + (hgrn ? 0 : bj * 128) + cbase), g1 = *(const f32x4*)(gain + (hgrn ? 0 : bj * 128) + cbase + 4);
#pragma unroll
        for (int ai = 0; ai < 2; ++ai)
#pragma unroll
            for (int m = 0; m < 4; ++m) { const int rl = rloc + ai * 128 + m * 16;
                const f32x4 x0 = *(const LAS f32x4*)(X + (rl * 2 + 0) * 4), x1 = *(const LAS f32x4*)(X + (rl * 2 + 1) * 4);
                const float t0 = (x0[0] + x0[1]) + (x0[2] + x0[3]), t1 = (x1[0] + x1[1]) + (x1[2] + x1[3]);
                const float rs = hgrn ? rsqrtf((bj ? t1 : t0) * (1.f / 128.f) + 1e-6f) : rsqrtf((t0 + t1) * (1.f / 256.f) + 1e-6f);
                const size_t idx = (size_t)(u.pm * 256 + rl) * 1024 + j * 256 + bj * 128 + cbase;
                const u32x4 a = *(const u32x4*)(Of + idx), b = *(const u32x4*)(Ob + idx);
                float fa[8], fb[8]; unpack8(a, fa); unpack8(b, fb);
                f32x4 r0, r1;
#pragma unroll
                for (int e = 0; e < 4; ++e) { const float ga = acc[ai][bj][m][0][e], gb = acc[ai][bj][m][1][e];
                    r0[e] = (fa[e] + fb[e]) * rs * g0[e] * (ga * sigmoidf_(ga)); r1[e] = (fa[4 + e] + fb[4 + e]) * rs * g1[e] * (gb * sigmoidf_(gb)); }
                asm volatile("" : "+v"(r0), "+v"(r1));
                *(u32x4*)(A1 + (size_t)(u.pm * 256 + rl) * 2048 + j * 256 + bj * 128 + cbase) = pack8(r0, r1); }
    }
    asm volatile("s_waitcnt lgkmcnt(0)" ::: "memory"); __builtin_amdgcn_s_barrier(); asm volatile("" ::: "memory");
}

__device__ __forceinline__ void epilogue(const Params& p, int phase, const Unit& u, const f32x4 (&acc)[2][2][4][2], int wr, int wc, int fr, int fq, LAS unsigned char* lds) {
    unsigned char* ws = p.ws;
    const int rbase = u.pm * 256 + wr * 64 + fr, cbase = wc * 32 + 8 * fq;
    if (phase == 1 || phase == 2) {
        const int pn = u.pn;
        int kind; unsigned char* dbase = ws; size_t doff; int ld = 1024, col0; float scale = 1.f;
        if (pn < 2) { kind = 0; doff = OFF_Q; ld = 512; col0 = pn * 256; scale = 0.08838834764831845f; }
        else if (pn < 4) { kind = 0; doff = OFF_K; ld = 512; col0 = (pn - 2) * 256; }
        else if (pn < 8) { kind = 0; doff = OFF_V; col0 = (pn - 4) * 256; }
        else if (pn < 10) { kind = 5; doff = OFF_EAF; ld = 512; col0 = (pn - 8) * 256; }
        else if (pn < 12) { kind = 6; doff = OFF_EAB; ld = 512; col0 = (pn - 10) * 256; }
        else if (pn < 16) { kind = 1; doff = OFF_HQ; col0 = (pn - 12) * 256; scale = 0.08838834764831845f; }
        else if (pn < 20) { kind = 3; doff = OFF_EF; col0 = (pn - 16) * 256; }
        else if (pn < 24) { kind = 4; dbase = g_ext; doff = X_EB; col0 = (pn - 20) * 256; }
        else if (pn < 28) { kind = 0; doff = OFF_HV; col0 = (pn - 24) * 256; }
        else if (pn < 32) { gate_norm_epi(p, u, acc, false, pn - 28, lds); return; }
        else if (pn < 36) { gate_norm_epi(p, u, acc, true, pn - 32, lds); return; }
        else if (pn < 40) { kind = 2; doff = OFF_MG; col0 = (pn - 36) * 256; }
        else { kind = 2; doff = OFF_MH; col0 = (pn - 40) * 256; }
        u16* D = (u16*)(dbase + doff);
        if (kind == 0) {
#pragma unroll
            for (int ai = 0; ai < 2; ++ai)
#pragma unroll
                for (int m = 0; m < 4; ++m)
#pragma unroll
                    for (int bj = 0; bj < 2; ++bj) { u16* dst = D + (size_t)(rbase + ai * 128 + m * 16) * ld + col0 + bj * 128 + cbase;
                        *(u32x4*)dst = pack8(acc[ai][bj][m][0] * scale, acc[ai][bj][m][1] * scale); }
        } else if (kind == 1) {
#pragma unroll
            for (int ai = 0; ai < 2; ++ai)
#pragma unroll
                for (int m = 0; m < 4; ++m)
#pragma unroll
                    for (int bj = 0; bj < 2; ++bj) { u16* dst = D + (size_t)(rbase + ai * 128 + m * 16) * ld + col0 + bj * 128 + cbase;
                        f32x4 a = acc[ai][bj][m][0], b = acc[ai][bj][m][1];
#pragma unroll
                        for (int e = 0; e < 4; ++e) { a[e] = a[e] * sigmoidf_(a[e]) * scale; b[e] = b[e] * sigmoidf_(b[e]) * scale; }
                        *(u32x4*)dst = pack8(a, b); }
        } else if (kind == 2) {
#pragma unroll
            for (int ai = 0; ai < 2; ++ai)
#pragma unroll
                for (int m = 0; m < 4; ++m)
#pragma unroll
                    for (int bj = 0; bj < 2; ++bj) { u16* dst = D + (size_t)(rbase + ai * 128 + m * 16) * ld + col0 + bj * 128 + cbase;
                        f32x4 a = acc[ai][bj][m][0], b = acc[ai][bj][m][1];
#pragma unroll
                        for (int e = 0; e < 4; ++e) { a[e] = sigmoidf_(a[e]); b[e] = sigmoidf_(b[e]); }
                        *(u32x4*)dst = pack8(a, b); }
        } else {
            u16* D2 = (u16*)(g_ext + ((kind == 4) ? X_KEB : X_KEF));
            const float* lbp = (const float*)(ws + OFF_LB);
            if (kind == 3) decay_epi<true, false>(acc, D, D2, lbp, ld, col0, rbase, cbase);
            else if (kind == 4) decay_epi<true, true>(acc, D, D2, lbp + 1024, ld, col0, rbase, cbase);
            else if (kind == 5) decay_epi<false, false>(acc, D, D2, p.bias_f, ld, col0, rbase, cbase);
            else decay_epi<false, true>(acc, D, D2, p.bias_b, ld, col0, rbase, cbase);
        }
    } else if (phase == 4) {
        const int g = u.pn >> 2, j = u.pn & 3;
        const u16* Gt = (const u16*)(ws + (g ? OFF_MH : OFF_MG));
        u16* Y = (u16*)(g_ext + X_Y);
#pragma unroll
        for (int ai = 0; ai < 2; ++ai)
#pragma unroll
            for (int m = 0; m < 4; ++m)
#pragma unroll
                for (int bj = 0; bj < 2; ++bj) { const size_t idx = (size_t)(rbase + ai * 128 + m * 16) * 1024 + j * 256 + bj * 128 + cbase;
                    const u32x4 gw = *(const u32x4*)(Gt + idx);
                    f32x4 a = acc[ai][bj][m][0], b = acc[ai][bj][m][1];
                    a[0] *= bflo(gw.x); a[1] *= bfhi(gw.x); a[2] *= bflo(gw.y); a[3] *= bfhi(gw.y);
                    b[0] *= bflo(gw.z); b[1] *= bfhi(gw.z); b[2] *= bflo(gw.w); b[3] *= bfhi(gw.w);
                    if (g) { const u32x4 yw = *(const u32x4*)(Y + idx);
                        a[0] += bflo(yw.x); a[1] += bfhi(yw.x); a[2] += bflo(yw.y); a[3] += bfhi(yw.y);
                        b[0] += bflo(yw.z); b[1] += bfhi(yw.z); b[2] += bflo(yw.w); b[3] += bfhi(yw.w); }
                    *(u32x4*)(Y + idx) = pack8(a, b); }
    } else {
        const float alpha = 1.189207115002721f;
#pragma unroll
        for (int ai = 0; ai < 2; ++ai)
#pragma unroll
            for (int m = 0; m < 4; ++m)
#pragma unroll
                for (int bj = 0; bj < 2; ++bj) { const size_t idx = (size_t)(rbase + ai * 128 + m * 16) * 1024 + u.pn * 256 + bj * 128 + cbase;
                    const f32x4 x0 = *(const f32x4*)(p.x + idx), x1 = *(const f32x4*)(p.x + idx + 4);
                    *(f32x4*)(p.out + idx) = acc[ai][bj][m][0] + alpha * x0; *(f32x4*)(p.out + idx + 4) = acc[ai][bj][m][1] + alpha * x1; }
    }
}

constexpr size_t OFF_XBUF = 61 * MiB + 64 * 1024;
constexpr int LN_CNT_WORD0 = XCD_BAR_WORDS + 1024;
__device__ __forceinline__ void ln_epilogue(const Params& p, const Unit& u, f32x4 (&v)[2][2][4][2], int, int, int, int, LAS unsigned char* lds, int, int) {
    int tidx = threadIdx.x; asm volatile("" : "+v"(tidx));
    const int lane = tidx & 63, wid = __builtin_amdgcn_readfirstlane(tidx >> 6), wr = wid >> 2, wc = wid & 3, fr = lane & 15, fq = lane >> 4;
    LAS f32x2* P = (LAS f32x2*)lds;
    LAS f32x2* S = (LAS f32x2*)(lds + 8192);
    unsigned long long* xbuf = (unsigned long long*)(p.ws + OFF_XBUF);
    unsigned* cnt = (unsigned*)(p.ws + OFF_BAR) + LN_CNT_WORD0 + 64 * u.pm;
    const float alpha = 1.189207115002721f;
    const int rbase = u.pm * 256 + wr * 64 + fr, cbase = u.pn * 256 + wc * 32 + 8 * fq;
#pragma unroll
    for (int ai = 0; ai < 2; ++ai)
#pragma unroll
        for (int m = 0; m < 4; ++m)
#pragma unroll
            for (int bj = 0; bj < 2; ++bj) { const size_t idx = (size_t)(rbase + ai * 128 + m * 16) * 1024 + cbase + bj * 128;
                const f32x4 x0 = *(const f32x4*)(p.x + idx), x1 = *(const f32x4*)(p.x + idx + 4);
                v[ai][bj][m][0] += alpha * x0; v[ai][bj][m][1] += alpha * x1;
                asm volatile("" : "+v"(v[ai][bj][m][0]), "+v"(v[ai][bj][m][1]));
            }
#pragma unroll
    for (int ai = 0; ai < 2; ++ai)
#pragma unroll
        for (int m = 0; m < 4; ++m) {
            float s = 0.f;
#pragma unroll
            for (int bj = 0; bj < 2; ++bj)
#pragma unroll
                for (int n = 0; n < 2; ++n) { const f32x4 x = v[ai][bj][m][n]; s += (x[0] + x[1]) + (x[2] + x[3]); }
            s += __shfl_xor(s, 16); s += __shfl_xor(s, 32);
            const float mw = s * (1.0f / 64.0f); float q = 0.f;
#pragma unroll
            for (int bj = 0; bj < 2; ++bj)
#pragma unroll
                for (int n = 0; n < 2; ++n) { const f32x4 d = v[ai][bj][m][n] - mw; q += (d[0] * d[0] + d[1] * d[1]) + (d[2] * d[2] + d[3] * d[3]); }
            q += __shfl_xor(q, 16); q += __shfl_xor(q, 32);
            if (fq == 0) P[(ai * 128 + wr * 64 + m * 16 + fr) * 4 + wc] = (f32x2){mw, q};
        }
    __syncthreads();
    const int row = wid * 32 + (lane & 31);
    if (lane < 32) {
        const f32x2 a = P[row * 4 + 0], b = P[row * 4 + 1], c = P[row * 4 + 2], d = P[row * 4 + 3];
        const float mt = (a.x + b.x + c.x + d.x) * 0.25f;
        const float da = a.x - mt, db = b.x - mt, dc = c.x - mt, dd = d.x - mt;
        const float m2 = (a.y + b.y) + (c.y + d.y) + 64.0f * ((da * da + db * db) + (dc * dc + dd * dd));
        unsigned long long* slot = xbuf + ((size_t)(u.pm * 256 + row) * 4 + u.pn);
        __hip_atomic_store(slot, ((unsigned long long)__float_as_uint(m2) << 32) | __float_as_uint(mt), __ATOMIC_RELAXED, __HIP_MEMORY_SCOPE_AGENT);
    }
    asm volatile("s_waitcnt vmcnt(0)" ::: "memory");
    if (lane == 0) __hip_atomic_fetch_add(cnt, 1u, __ATOMIC_RELAXED, __HIP_MEMORY_SCOPE_AGENT);
    if (wid == 0) {
        unsigned sp = 0;
        while ((unsigned)__builtin_amdgcn_readfirstlane(__hip_atomic_load(cnt, __ATOMIC_RELAXED, __HIP_MEMORY_SCOPE_AGENT)) < 32u) { __builtin_amdgcn_s_sleep(2); if (++sp > (1u << 20)) break; }
        __builtin_amdgcn_fence(__ATOMIC_ACQUIRE, "agent");
    }
    asm volatile("s_waitcnt vmcnt(0) lgkmcnt(0)" ::: "memory");
    __syncthreads();
    if (lane < 32) {
        const unsigned long long* slot = xbuf + (size_t)(u.pm * 256 + row) * 4; float mt[4], m2[4]; float ms = 0.f;
#pragma unroll
        for (int t = 0; t < 4; ++t) { const unsigned long long w = __hip_atomic_load(slot + t, __ATOMIC_RELAXED, __HIP_MEMORY_SCOPE_AGENT); mt[t] = __uint_as_float((unsigned)w); m2[t] = __uint_as_float((unsigned)(w >> 32)); ms += mt[t]; }
        const float mean = ms * 0.25f; float q = 0.f;
#pragma unroll
        for (int t = 0; t < 4; ++t) { const float dm = mt[t] - mean; q += m2[t] + 256.0f * dm * dm; }
        S[row] = (f32x2){mean, 1.0f / sqrtf(q * (1.0f / 1024.0f) + 1e-5f)};
    }
    __syncthreads();
#pragma unroll
    for (int bj = 0; bj < 2; ++bj) {
        const f32x4 g0 = *(const f32x4*)(p.ln_g + cbase + bj * 128), g1 = *(const f32x4*)(p.ln_g + cbase + bj * 128 + 4);
        const f32x4 b0 = *(const f32x4*)(p.ln_b + cbase + bj * 128), b1 = *(const f32x4*)(p.ln_b + cbase + bj * 128 + 4);
#pragma unroll
        for (int ai = 0; ai < 2; ++ai)
#pragma unroll
            for (int m = 0; m < 4; ++m) { const int rl = ai * 128 + wr * 64 + m * 16 + fr; const f32x2 st = S[rl];
                const size_t idx = (size_t)(u.pm * 256 + rl) * 1024 + cbase + bj * 128;
                *(f32x4*)(p.out + idx) = (v[ai][bj][m][0] - st.x) * st.y * g0 + b0;
                *(f32x4*)(p.out + idx + 4) = (v[ai][bj][m][1] - st.x) * st.y * g1 + b1; }
    }
}

__device__ __forceinline__ void gemm_phase(const Params& p, LAS unsigned char* lds, const Sched& S, int lda, int ldb, int K) {
    int tid = threadIdx.x; asm volatile("" : "+v"(tid));
    const int wid = __builtin_amdgcn_readfirstlane(tid >> 6), lane = tid & 63, wr = wid >> 2, wc = wid & 3, fr = lane & 15, fq = lane >> 4;
    const int nt = K / BK;
    unsigned voffA[2], voffB[2];
#pragma unroll
    for (int i = 0; i < 2; ++i) { int R, C; stage_rc(tid * 16 + i * 8192, R, C); const int Rb = (R & ~31) + perm32(R & 31);
        voffA[i] = (unsigned)(R * lda + C) * 2u; voffB[i] = (unsigned)(Rb * ldb + C) * 2u; }
    const size_t kstep = (size_t)(BK * 2);
    const size_t hstepA = (size_t)HALF * lda * 2, hstepB = (size_t)HALF * ldb * 2;
    const unsigned ldsw = (unsigned)wid * 1024u;
    const int aoff = lds_byte(wr * 64 + fr, fq * 8), boff = lds_byte(wc * 32 + fr, fq * 8);
#define G_SA(b, h) (((b) * 2 + (h)) * HTB)
#define G_SB(b, h) ((4 + (b) * 2 + (h)) * HTB)
#define G_STAGE(bufoff, gbase, voff) do { _Pragma("unroll") for (int _i = 0; _i < 2; ++_i) \
        __builtin_amdgcn_global_load_lds((const unsigned*)((const char*)(gbase) + (voff)[_i]), (LAS unsigned*)(lds + (bufoff) + ldsw + _i * 8192), 16, 0, 0); } while (0)
#define G_LDA(dst, b, h) do { _Pragma("unroll") for (int m = 0; m < 4; ++m) _Pragma("unroll") for (int k = 0; k < 2; ++k) dst[m][k] = *(const LAS bf16x8*)(lds + G_SA(b, h) + aoff + m * 2048 + k * 1024); } while (0)
#define G_LDB(dst, b, h) do { _Pragma("unroll") for (int n = 0; n < 2; ++n) _Pragma("unroll") for (int k = 0; k < 2; ++k) dst[n][k] = *(const LAS bf16x8*)(lds + G_SB(b, h) + boff + n * 2048 + k * 1024); } while (0)
#define G_MMA(ai, bj, At, Bt) do { __builtin_amdgcn_s_setprio(1); _Pragma("unroll") for (int m = 0; m < 4; ++m) _Pragma("unroll") for (int n = 0; n < 2; ++n) _Pragma("unroll") for (int k = 0; k < 2; ++k) \
        acc[ai][bj][m][n] = __builtin_amdgcn_mfma_f32_16x16x32_bf16(Bt[n][k], At[m][k], acc[ai][bj][m][n], 0, 0, 0); __builtin_amdgcn_s_setprio(0); } while (0)
#define G_WAIT_V(n) asm volatile("s_waitcnt vmcnt(" #n ")" ::: "memory")
#define G_WAIT_L(n) asm volatile("s_waitcnt lgkmcnt(" #n ")" ::: "memory")
#define G_BAR __builtin_amdgcn_s_barrier()
#define G_SCHED __builtin_amdgcn_sched_barrier(0)
    Unit cur, nxt; int ui = 0;
    if (!S.next(0, cur)) return;
    f32x4 acc[2][2][4][2];
#pragma unroll
    for (int a = 0; a < 2; ++a)
#pragma unroll
        for (int b = 0; b < 2; ++b)
#pragma unroll
            for (int m = 0; m < 4; ++m)
#pragma unroll
                for (int n = 0; n < 2; ++n) acc[a][b][m][n] = (f32x4){0.f, 0.f, 0.f, 0.f};
    bf16x8 At[4][2], B0[2][2], B1[2][2];
    const char* cA = cur.a; const char* cB = cur.b;
    G_STAGE(G_SB(0, 0), cB, voffB); G_STAGE(G_SB(0, 1), cB + hstepB, voffB); G_STAGE(G_SA(0, 0), cA, voffA); G_STAGE(G_SA(0, 1), cA + hstepA, voffA);
    if (wr == 1) G_BAR;
    G_WAIT_V(2); G_BAR;
    G_STAGE(G_SB(1, 0), cB + kstep, voffB); G_STAGE(G_SA(1, 0), cA + kstep, voffA); G_STAGE(G_SB(1, 1), cB + hstepB + kstep, voffB);
    G_WAIT_V(6); G_BAR;
    for (;;) {
        const bool has_next = S.next(ui + 1, nxt);
        const char* nA = has_next ? nxt.a : cA; const char* nB = has_next ? nxt.b : cB;
        for (int t = 0; t < nt; t += 2) {
            const bool last = (t == nt - 2);
            const char* a1 = cA + (size_t)(t + 1) * kstep;
            const char* a2 = last ? nA : cA + (size_t)(t + 2) * kstep; const char* b2 = last ? nB : cB + (size_t)(t + 2) * kstep;
            const char* a3 = a2 + kstep; const char* b3 = b2 + kstep;
            G_LDB(B0, 0, 0); G_LDB(B1, 0, 1); G_SCHED; G_LDA(At, 0, 0); G_STAGE(G_SA(1, 1), a1 + hstepA, voffA);
            G_WAIT_V(8); G_WAIT_L(0); G_BAR; G_MMA(0, 0, At, B0); G_MMA(0, 1, At, B1); G_BAR; G_SCHED;
            G_LDA(At, 0, 1); G_STAGE(G_SB(0, 0), b2, voffB); G_STAGE(G_SB(0, 1), b2 + hstepB, voffB); G_STAGE(G_SA(0, 0), a2, voffA);
            G_WAIT_V(8); G_WAIT_L(0); G_BAR; G_MMA(1, 0, At, B0); G_MMA(1, 1, At, B1); G_BAR; G_SCHED;
            G_LDB(B0, 1, 0); G_LDB(B1, 1, 1); G_SCHED; G_LDA(At, 1, 0); G_STAGE(G_SA(0, 1), a2 + hstepA, voffA);
            G_WAIT_V(8); G_WAIT_L(0); G_BAR; G_MMA(0, 0, At, B0); G_MMA(0, 1, At, B1); G_BAR; G_SCHED;
            G_LDA(At, 1, 1); G_STAGE(G_SB(1, 0), b3, voffB); G_STAGE(G_SB(1, 1), b3 + hstepB, voffB); G_STAGE(G_SA(1, 0), a3, voffA);
            G_WAIT_V(8); G_WAIT_L(0); G_BAR; G_MMA(1, 0, At, B0); G_MMA(1, 1, At, B1); G_BAR; G_SCHED;
        }
        if (wr == 0) G_BAR;
        if (S.phase != 5) epilogue(p, S.phase, cur, acc, wr, wc, fr, fq, lds);
        if (!has_next) break;
#pragma unroll
        for (int a = 0; a < 2; ++a)
#pragma unroll
            for (int b = 0; b < 2; ++b)
#pragma unroll
                for (int m = 0; m < 4; ++m)
#pragma unroll
                    for (int n = 0; n < 2; ++n) acc[a][b][m][n] = (f32x4){0.f, 0.f, 0.f, 0.f};
        cur = nxt; cA = nA; cB = nB; ++ui;
        if (wr == 1) G_BAR;
    }
    G_WAIT_V(0);
    G_BAR;
    if (S.phase == 5) ln_epilogue(p, cur, acc, wr, wc, fr, fq, lds, wid, lane);
}

__device__ __forceinline__ void phase0(const Params& p, LAS unsigned char* lds) {
    const int tid = threadIdx.x;
    const size_t gtid = (size_t)blockIdx.x * 512 + tid, gsz = (size_t)gridDim.x * 512;
    {
        const f32x4* x4 = (const f32x4*)p.x; u32x4* xb = (u32x4*)(p.ws + OFF_XB);
        const size_t n8 = (size_t)MTOK * DM / 8;
        for (size_t i = gtid; i < n8; i += gsz) { const f32x4 a = x4[2 * i], b = x4[2 * i + 1]; xb[i] = pack8(a, b); }
    }
    if (gtid < 2048) {
        const int d = (int)gtid & 1023; const float* L = (gtid < 1024) ? p.lbl_f : p.lbl_b;
        const float l0 = L[d], l1 = L[1024 + d];
        ((float*)(p.ws + OFF_LB))[gtid] = 1.f / (1.f + expf(l1 - l0));
    }
    LAS float* T = (LAS float*)lds;
    for (int job = blockIdx.x; job < 1408 + 384; job += gridDim.x) {
        const float* src; u16* dst; int ldw, nt64, kt, isin;
        if (job < 1408) { isin = 1; src = p.w_in; ldw = NIN; dst = (u16*)(p.ws + OFF_WINT); nt64 = job >> 3; kt = job & 7; }
        else { const int jj = job - 1408, mat = jj >> 7, r = jj & 127; isin = 0; ldw = 1024; nt64 = r >> 3; kt = r & 7;
            src = mat == 0 ? p.w_gla : (mat == 1 ? p.w_hgrn : p.w_out); dst = (u16*)(p.ws + (mat == 0 ? OFF_WGT : (mat == 1 ? OFF_WHT : OFF_WOT))); }
        const int c = tid & 63, kr = tid >> 6;
        const int m = nt64 * 64 + c;
        int orig = m; int eff = 0;
        if (isin) {
            if (m < 2048) orig = m;
            else if (m < 3072) { eff = 1; orig = m - 2048; }
            else if (m < 7168) orig = m + 32;
            else if (m < 8192) orig = 2048 + (m - 7168);
            else orig = 7200 + (m - 8192);
        }
        if (eff) {
            const int bw = orig >> 9, cc = orig & 511;
            const float* U = bw ? p.up_b : p.up_f;
            float uv[16];
#pragma unroll
            for (int r = 0; r < 16; ++r) uv[r] = U[r * 512 + cc];
            for (int i = 0; i < 16; ++i) { const int k = kr + 8 * i;
                const float* wr_ = src + (size_t)(kt * 128 + k) * ldw + 3072 + bw * 16;
                float s = 0.f;
#pragma unroll
                for (int r = 0; r < 16; ++r) s += wr_[r] * uv[r];
                T[k * 65 + c] = s; }
        } else {
#pragma unroll 4
            for (int i = 0; i < 16; ++i) { const int k = kr + 8 * i;
                T[k * 65 + c] = src[(size_t)(kt * 128 + k) * ldw + orig]; }
        }
        __syncthreads();
        const int rho = tid >> 3, kseg = tid & 7;
        float v[16];
#pragma unroll
        for (int kk = 0; kk < 16; ++kk) v[kk] = T[(kseg * 16 + kk) * 65 + rho];
        u32x4 w0, w1;
        w0.x = pk_bf16(v[0], v[1]); w0.y = pk_bf16(v[2], v[3]); w0.z = pk_bf16(v[4], v[5]); w0.w = pk_bf16(v[6], v[7]);
        w1.x = pk_bf16(v[8], v[9]); w1.y = pk_bf16(v[10], v[11]); w1.z = pk_bf16(v[12], v[13]); w1.w = pk_bf16(v[14], v[15]);
        u16* d = dst + (size_t)(nt64 * 64 + rho) * 1024 + kt * 128 + kseg * 16;
        *(u32x4*)d = w0; *(u32x4*)(d + 8) = w1;
        __syncthreads();
    }
}

constexpr int S_QE = 0, S_KE = 19456, S_V = 38912, S_PP = 48128, S_ST0 = 57344, S_ST1 = 76800, S_DEC = 96256;
constexpr int RS = 304, RV = 144;
typedef short s16x4 __attribute__((ext_vector_type(4)));
#define MFMA16(a, b, c) __builtin_amdgcn_mfma_f32_16x16x32_bf16(a, b, c, 0, 0, 0)

__device__ __forceinline__ bf16x8 tr8(LAS unsigned char* p0, int stride4) {
    const s16x4 a = __builtin_amdgcn_ds_read_tr16_b64_v4i16((LAS s16x4*)p0);
    const s16x4 b = __builtin_amdgcn_ds_read_tr16_b64_v4i16((LAS s16x4*)(p0 + stride4));
    return __builtin_shufflevector(a, b, 0, 1, 2, 3, 4, 5, 6, 7);
}

__device__ __forceinline__ void scan_phase(const Params& p, LAS unsigned char* lds) {
    const int tid = threadIdx.x, w = __builtin_amdgcn_readfirstlane(tid >> 6), lane = tid & 63, fr = lane & 15, fq = lane >> 4;
    const int ti = tid >> 3, ch = tid & 7;
    for (int u = blockIdx.x; u < 256; u += gridDim.x) {
        const int xcd = u & 7, slot = u >> 3;
        const bool isg = slot < 16;
        int bb, hh, dir, e0, ldq;
        const u16 *Qp, *Ep, *Kp, *Vp; u16* Op;
        if (isg) { const int grp = xcd + 8 * (slot >> 2), sl = slot & 3; bb = grp >> 3; hh = (grp >> 1) & 3; dir = grp & 1; e0 = hh * 256 + sl * 64; ldq = 512;
            Qp = (const u16*)(p.ws + OFF_Q); Kp = (const u16*)(p.ws + OFF_K); Ep = (const u16*)(p.ws + (dir ? OFF_EAB : OFF_EAF)); Vp = (const u16*)(p.ws + OFF_V);
            Op = (u16*)((unsigned char*)p.out + (dir ? OFF_OAB : OFF_OAF)); }
        else { const int s = slot - 16, grp = xcd + 8 * (s >> 1), sl = s & 1; bb = grp >> 4; hh = (grp >> 1) & 7; dir = grp & 1; e0 = hh * 128 + sl * 64; ldq = 1024;
            Qp = (const u16*)(p.ws + OFF_HQ); Vp = (const u16*)(p.ws + OFF_HV);
            Ep = dir ? (const u16*)(g_ext + X_EB) : (const u16*)(p.ws + OFF_EF); Kp = (const u16*)(g_ext + (dir ? X_KEB : X_KEF));
            Op = (u16*)(g_ext + (dir ? X_OHB : X_OHF)); }
        const int qc = hh * 128 + ch * 8;
        const int tb = bb * SEQ, sgn = dir ? -1 : 1;
        for (int i = tid; i < 19456 / 4; i += 512) *(LAS unsigned*)(lds + S_ST0 + i * 4) = 0u;
        f32x4 sacc[4];
#pragma unroll
        for (int ne = 0; ne < 4; ++ne) sacc[ne] = (f32x4){0.f, 0.f, 0.f, 0.f};
        u32x4 rq[2], re[2], rk[2], rv;
        {
            const size_t t = (size_t)(tb + (dir ? SEQ - 1 : 0) + sgn * ti);
            rq[0] = *(const u32x4*)(Qp + t * ldq + qc); rq[1] = *(const u32x4*)(Qp + t * ldq + qc + 64);
            re[0] = *(const u32x4*)(Ep + t * ldq + qc); re[1] = *(const u32x4*)(Ep + t * ldq + qc + 64);
            rk[0] = *(const u32x4*)(Kp + t * ldq + qc); rk[1] = *(const u32x4*)(Kp + t * ldq + qc + 64);
            rv = *(const u32x4*)(Vp + t * 1024 + e0 + ch * 8);
        }
        __syncthreads();
        for (int c = 0; c < 64; ++c) {
            const int base = tb + (dir ? SEQ - 1 - 64 * c : 64 * c);
#pragma unroll
            for (int hf = 0; hf < 2; ++hf) {
                float q[8], e[8];
                unpack8(rq[hf], q); unpack8(re[hf], e);
                f32x4 a0, a1;
#pragma unroll
                for (int x = 0; x < 4; ++x) { a0[x] = q[x] * e[x]; a1[x] = q[4 + x] * e[4 + x]; }
                *(LAS u32x4*)(lds + S_QE + ti * RS + ch * 16 + hf * 128) = pack8(a0, a1);
                if (isg) { float k[8]; unpack8(rk[hf], k);
#pragma unroll
                    for (int x = 0; x < 4; ++x) { a0[x] = k[x] * __builtin_amdgcn_rcpf(e[x]); a1[x] = k[4 + x] * __builtin_amdgcn_rcpf(e[4 + x]); }
                    *(LAS u32x4*)(lds + S_KE + ti * RS + ch * 16 + hf * 128) = pack8(a0, a1); }
                else *(LAS u32x4*)(lds + S_KE + ti * RS + ch * 16 + hf * 128) = rk[hf];
                if (ti == 63) { *(LAS f32x4*)(lds + S_DEC + (ch * 8 + hf * 64) * 4) = (f32x4){e[0], e[1], e[2], e[3]}; *(LAS f32x4*)(lds + S_DEC + (ch * 8 + hf * 64 + 4) * 4) = (f32x4){e[4], e[5], e[6], e[7]}; }
            }
            *(LAS u32x4*)(lds + S_V + ti * RV + ch * 16) = rv;
            if (c < 63) {
                const size_t t = (size_t)(tb + (dir ? SEQ - 1 - 64 * (c + 1) : 64 * (c + 1)) + sgn * ti);
                rq[0] = *(const u32x4*)(Qp + t * ldq + qc); rq[1] = *(const u32x4*)(Qp + t * ldq + qc + 64);
                re[0] = *(const u32x4*)(Ep + t * ldq + qc); re[1] = *(const u32x4*)(Ep + t * ldq + qc + 64);
                rk[0] = *(const u32x4*)(Kp + t * ldq + qc); rk[1] = *(const u32x4*)(Kp + t * ldq + qc + 64);
                rv = *(const u32x4*)(Vp + t * 1024 + e0 + ch * 8);
            }
            __syncthreads();
            bf16x8 bqs[4], vfr[2][2];
            {
                const int mi = w >> 1, njb = (w & 1) * 2;
                f32x4 sc[2]; sc[0] = (f32x4){0.f, 0.f, 0.f, 0.f}; sc[1] = sc[0];
#pragma unroll
                for (int kk = 0; kk < 4; ++kk) { const bf16x8 bq = *(const LAS bf16x8*)(lds + S_QE + (16 * mi + fr) * RS + (32 * kk + 8 * fq) * 2); bqs[kk] = bq;
#pragma unroll
                    for (int n2 = 0; n2 < 2; ++n2) if (njb + n2 <= mi) {
                        const bf16x8 ak = *(const LAS bf16x8*)(lds + S_KE + (16 * (njb + n2) + fr) * RS + (32 * kk + 8 * fq) * 2); sc[n2] = MFMA16(ak, bq, sc[n2]); } }
                const int i = 16 * mi + fr;
#pragma unroll
                for (int n2 = 0; n2 < 2; ++n2) { const int j0 = 16 * (njb + n2) + 4 * fq;
                    const float m0 = (i >= j0) ? sc[n2][0] : 0.f, m1 = (i >= j0 + 1) ? sc[n2][1] : 0.f, m2 = (i >= j0 + 2) ? sc[n2][2] : 0.f, m3 = (i >= j0 + 3) ? sc[n2][3] : 0.f;
                    *(LAS u32x2*)(lds + S_PP + i * RV + j0 * 2) = (u32x2){pk_bf16(m0, m1), pk_bf16(m2, m3)}; }
            }
            const int stold = (c & 1) ? S_ST1 : S_ST0, stnew = (c & 1) ? S_ST0 : S_ST1;
            {
                const int dq = w >> 1, eh = w & 1;
#pragma unroll
                for (int kk = 0; kk < 2; ++kk) {
                    const int jr = 32 * kk + 8 * fq + (fr >> 2);
                    bf16x8 a2[2];
#pragma unroll
                    for (int db = 0; db < 2; ++db) a2[db] = tr8(lds + S_KE + jr * RS + (16 * (2 * dq + db) + 4 * (fr & 3)) * 2, 4 * RS);
#pragma unroll
                    for (int eb = 0; eb < 2; ++eb) { const bf16x8 bv = tr8(lds + S_V + jr * RV + (16 * (2 * eh + eb) + 4 * (fr & 3)) * 2, 4 * RV);
                        vfr[kk][eb] = bv;
#pragma unroll
                        for (int db = 0; db < 2; ++db) sacc[2 * db + eb] = MFMA16(a2[db], bv, sacc[2 * db + eb]); } }
#pragma unroll
                for (int db = 0; db < 2; ++db) { const f32x4 dec = *(const LAS f32x4*)(lds + S_DEC + (16 * (2 * dq + db) + 4 * fq) * 4);
#pragma unroll
                    for (int eb = 0; eb < 2; ++eb) { sacc[2 * db + eb] = sacc[2 * db + eb] * dec;
                        *(LAS u32x2*)(lds + stnew + (16 * (2 * eh + eb) + fr) * RS + (16 * (2 * dq + db) + 4 * fq) * 2) = (u32x2){pk_bf16(sacc[2 * db + eb][0], sacc[2 * db + eb][1]), pk_bf16(sacc[2 * db + eb][2], sacc[2 * db + eb][3])}; } }
            }
            __syncthreads();
            {
                const int mi = w >> 1, neb = (w & 1) * 2;
                f32x4 oa[2]; oa[0] = (f32x4){0.f, 0.f, 0.f, 0.f}; oa[1] = oa[0];
#pragma unroll
                for (int kk = 0; kk < 4; ++kk) { const bf16x8 b = bqs[kk];
#pragma unroll
                    for (int n2 = 0; n2 < 2; ++n2) { const bf16x8 a = *(const LAS bf16x8*)(lds + stold + (16 * (neb + n2) + fr) * RS + (32 * kk + 8 * fq) * 2); oa[n2] = MFMA16(a, b, oa[n2]); } }
#pragma unroll
                for (int kk = 0; kk < 2; ++kk) { const bf16x8 b = *(const LAS bf16x8*)(lds + S_PP + (16 * mi + fr) * RV + (32 * kk + 8 * fq) * 2);
#pragma unroll
                    for (int n2 = 0; n2 < 2; ++n2) { oa[n2] = MFMA16(vfr[kk][n2], b, oa[n2]); } }
                u16* optr = Op + (size_t)(base + sgn * (16 * mi + fr)) * 1024 + e0 + 16 * neb + 4 * fq;
                *(u32x2*)optr = (u32x2){pk_bf16(oa[0][0], oa[0][1]), pk_bf16(oa[0][2], oa[0][3])};
                *(u32x2*)(optr + 16) = (u32x2){pk_bf16(oa[1][0], oa[1][1]), pk_bf16(oa[1][2], oa[1][3])};
            }
            __syncthreads();
        }
    }
}

#define XB_TMO      128
#define XB_XCNT(j)  (256  + 64 * (j))
#define XB_XSUB(j)  (1280 + 64 * (j))
#define XB_XGEN(j)  (2304 + 64 * (j))
#define XB_TOP      3328
#define XB_TOPGEN   3392
#define XB_SPIN_CAP (1u << 18)
__device__ __forceinline__ unsigned xb_ld(unsigned* p)              { return __hip_atomic_load(p, __ATOMIC_RELAXED, __HIP_MEMORY_SCOPE_AGENT); }
__device__ __forceinline__ unsigned xb_add(unsigned* p, unsigned v) { return __hip_atomic_fetch_add(p, v, __ATOMIC_RELAXED, __HIP_MEMORY_SCOPE_AGENT); }
__device__ __forceinline__ unsigned xb_xcc_id() { return (unsigned)__builtin_amdgcn_s_getreg((3 << 11) | 20) & 0xFu; }
#define XB_SPIN(cond, bar) do { unsigned _sp = 0; while (cond) { __builtin_amdgcn_s_sleep(1); \
    if ((++_sp & 255u) == 0u) { if (xb_ld(&(bar)[XB_TMO])) break; if (_sp > XB_SPIN_CAP) { atomicAdd(&(bar)[XB_TMO], 1u); break; } } } } while (0)
struct XcdBarrier { unsigned* bar; unsigned x; volatile LAS unsigned* st; };
__device__ __forceinline__ XcdBarrier xcd_barrier_post(unsigned* bar, volatile LAS unsigned* st) {
    XcdBarrier b; b.bar = bar; b.x = xb_xcc_id(); b.st = st;
    if (threadIdx.x == 0) (void)xb_add(&bar[XB_XCNT(b.x)], 1u);
    return b;
}
__device__ __forceinline__ void xcd_barrier_complete(unsigned* bar, unsigned x, unsigned& nloc, unsigned& nx) {
    const unsigned G = gridDim.x * gridDim.y * gridDim.z;
    unsigned sum, cnt, mine, sp = 0u;
    for (;;) {
        sum = 0u; cnt = 0u; mine = 0u;
#pragma unroll
        for (unsigned j = 0; j < 16; ++j) { const unsigned c = xb_ld(&bar[XB_XCNT(j)]); sum += c; cnt += (c > 0u) ? 1u : 0u; mine = (j == x) ? c : mine; }
        if (sum == G) break;
        __builtin_amdgcn_s_sleep(1);
        if ((++sp & 255u) == 0u) { if (xb_ld(&bar[XB_TMO])) break; if (sp > XB_SPIN_CAP) { atomicAdd(&bar[XB_TMO], 1u); break; } }
    }
    nloc = mine > 0u ? mine : 1u; nx = cnt > 0u ? cnt : 1u;
}
__device__ __forceinline__ void xcd_barrier(const XcdBarrier& b) {
    asm volatile("s_waitcnt vmcnt(0)" ::: "memory");
    __syncthreads();
    if (threadIdx.x == 0) {
        unsigned* bar = b.bar;
        __builtin_amdgcn_s_waitcnt(0);
        unsigned nloc = b.st[0], nx = b.st[1];
        if (nloc == 0u) { xcd_barrier_complete(bar, b.x, nloc, nx); b.st[0] = nloc; b.st[1] = nx; }
        const unsigned old = xb_add(&bar[XB_XSUB(b.x)], 1u);
        const unsigned gen = old / nloc;
        if (old + 1u == (gen + 1u) * nloc) {
            __builtin_amdgcn_fence(__ATOMIC_RELEASE, "agent");
            asm volatile("s_waitcnt vmcnt(0)" ::: "memory");
            const unsigned og = xb_add(&bar[XB_TOP], 1u);
            const unsigned tg = og / nx;
            if (og + 1u == (tg + 1u) * nx) xb_add(&bar[XB_TOPGEN], 1u);
            else XB_SPIN(xb_ld(&bar[XB_TOPGEN]) == tg, bar);
            __builtin_amdgcn_fence(__ATOMIC_ACQUIRE, "agent");
            xb_add(&bar[XB_XGEN(b.x)], 1u);
            asm volatile("s_waitcnt vmcnt(0)" ::: "memory");
        } else {
            XB_SPIN(xb_ld(&bar[XB_XGEN(b.x)]) == gen, bar);
            __builtin_amdgcn_fence(__ATOMIC_ACQUIRE, "agent");
            asm volatile("s_waitcnt vmcnt(0)" ::: "memory");
        }
    }
    __syncthreads();
}

__global__ void __launch_bounds__(512) mega(Params p) {
    extern __shared__ __attribute__((aligned(16))) unsigned char lds_raw[];
    LAS unsigned char* lds = (LAS unsigned char*)lds_raw;
    cg::grid_group grid = cg::this_grid();
    volatile LAS unsigned* xst = (volatile LAS unsigned*)(lds + 131072);
    if (threadIdx.x == 0) { xst[0] = 0u; xst[1] = 0u; xst[2] = 0u; xst[3] = 0u; }
    __syncthreads();
    const XcdBarrier xb = xcd_barrier_post((unsigned*)(p.ws + OFF_BAR), xst);
    Sched S; S.G = gridDim.x; S.c = blockIdx.x; S.ws = p.ws;
    if (p.ws == nullptr) grid.sync();
    phase0(p, lds);
    xcd_barrier(xb);
    S.phase = 1; S.nN = 28; S.ntiles = 64 * 28; S.nsub = 1;
    gemm_phase(p, lds, S, 1024, 1024, 1024);
    xcd_barrier(xb);
    scan_phase(p, lds);
    xcd_barrier(xb);
    S.phase = 2; S.nN = 16; S.ntiles = 64 * 16; S.nsub = 1;
    gemm_phase(p, lds, S, 1024, 1024, 1024);
    xcd_barrier(xb);
    S.phase = 4; S.nN = 4; S.ntiles = 256; S.nsub = 2;
    gemm_phase(p, lds, S, 2048, 1024, 1024);
    xcd_barrier(xb);
    S.phase = 5; S.nN = 4; S.ntiles = 256; S.nsub = 1;
    gemm_phase(p, lds, S, 1024, 1024, 1024);
}

extern "C" void kernel_launch(void* const* d_in, const int* in_sizes, int n_in,
                              void* d_out, int out_size, void* d_ws, size_t ws_size,
                              hipStream_t stream) {
    constexpr size_t kDynLds = 131088 + 8192;
    static int grid_blocks = 0;
    if (!grid_blocks) {
        int dev = 0, cus = 0, per_cu = 0;
        (void)hipGetDevice(&dev);
        (void)hipDeviceGetAttribute(&cus, hipDeviceAttributeMultiprocessorCount, dev);
        (void)hipFuncSetAttribute((const void*)mega, hipFuncAttributeMaxDynamicSharedMemorySize, (int)kDynLds);
        (void)hipOccupancyMaxActiveBlocksPerMultiprocessor(&per_cu, mega, 512, kDynLds);
        if (per_cu < 1) per_cu = 1;
        if (per_cu > 1) per_cu = 1;
        grid_blocks = cus * per_cu;
    }
    Params p{};
    p.x = (const float*)d_in[0]; p.w_in = (const float*)d_in[1]; p.up_f = (const float*)d_in[2]; p.bias_f = (const float*)d_in[3];
    p.up_b = (const float*)d_in[4]; p.bias_b = (const float*)d_in[5]; p.gla_g = (const float*)d_in[6]; p.lbl_f = (const float*)d_in[7];
    p.lbl_b = (const float*)d_in[8]; p.hg_g = (const float*)d_in[9]; p.w_gla = (const float*)d_in[10]; p.w_hgrn = (const float*)d_in[11];
    p.w_out = (const float*)d_in[12]; p.ln_g = (const float*)d_in[13]; p.ln_b = (const float*)d_in[14];
    p.out = (float*)d_out; p.ws = (unsigned char*)d_ws;
    (void)hipMemsetAsync((unsigned char*)d_ws + OFF_BAR, 0, (XCD_BAR_WORDS + 1024 + 64 * 64) * sizeof(unsigned), stream);
    void* args[] = {&p};
    hipError_t e = hipLaunchCooperativeKernel((void*)mega, dim3(grid_blocks), dim3(512), args, kDynLds, stream);
    if (e != hipSuccess) fprintf(stderr, "cooperative launch failed: %s (grid %d)\n", hipGetErrorString(e), grid_blocks);
}
```
